# Optimizing an MI355X kernel written in HIP

```python
import jax, jax.numpy as jnp
from jax import lax
import numpy as np

D_MODEL = 1024
BATCH = 8
SEQ = 2048
DEPTH = 4

BRANCH_WIDTH = D_MODEL // 2
N_BRANCH = 3
HGRN_KEY = 128
HGRN_VAL = 128
HGRN_HEADS = BRANCH_WIDTH // HGRN_KEY
HGRN_CHUNK = 64
LB_FLOOR = 1e-30
CONV_K = 3
SG_CHUNK = 128
SG_GROUPS = 4
SG_GROUP_DIM = BRANCH_WIDTH // SG_GROUPS
D_FF = 4 * D_MODEL
NORM_EPS = 1e-6
LN_EPS = 1e-5
IN_COLS = 9 * BRANCH_WIDTH + N_BRANCH * D_MODEL

kernel_name = 'hybrid_hgrn2_shortconv_spatialgate_block'


def rms_norm(x, g, eps=NORM_EPS):
    xf = x.astype(jnp.float32)
    y = xf * lax.rsqrt(jnp.mean(xf * xf, axis=-1, keepdims=True) + eps)
    return (y * g.astype(jnp.float32)).astype(x.dtype)


def layer_norm(x, g, b, eps=LN_EPS):
    xf = x.astype(jnp.float32)
    mu = jnp.mean(xf, axis=-1, keepdims=True)
    xc = xf - mu
    y = xc * lax.rsqrt(jnp.mean(xc * xc, axis=-1, keepdims=True) + eps)
    return (y * g.astype(jnp.float32) + b.astype(jnp.float32)).astype(x.dtype)


def hgrn2_mix(q, fp, iv, go, lb, g_out):
    B, S, _ = q.shape
    H, K, V, L = HGRN_HEADS, HGRN_KEY, HGRN_VAL, HGRN_CHUNK
    N = S // L
    f32 = jnp.float32
    q = jax.nn.silu(q.astype(f32))
    fp = fp.astype(f32)
    lb = lb.astype(f32)
    logf = jnp.logaddexp(jnp.log(jnp.maximum(lb, LB_FLOOR)),
                         jnp.log1p(-lb) + jax.nn.log_sigmoid(fp))
    k = (1.0 - lb) * jax.nn.sigmoid(-fp)
    v = iv.astype(f32)

    def to_chunks(t, d):
        return t.reshape(B, N, L, H, d).transpose(1, 0, 3, 2, 4)

    qs, ks, vs, ls = to_chunks(q, K), to_chunks(k, K), to_chunks(v, V), to_chunks(logf, K)
    causal = jnp.tril(jnp.ones((L, L), dtype=bool))[:, :, None]

    def step(state, inp):
        qc, kc, vc, lc = inp
        b = jnp.cumsum(lc, axis=2)
        diff = b[:, :, :, None, :] - b[:, :, None, :, :]
        decay = jnp.where(causal, jnp.exp(jnp.where(causal, diff, 0.0)), 0.0)
        attn = jnp.einsum('bhtk,bhsk,bhtsk->bhts', qc, kc, decay)
        o = (jnp.einsum('bhts,bhsv->bhtv', attn, vc)
             + jnp.einsum('bhtk,bhkv->bhtv', qc * jnp.exp(b), state))
        b_last = b[:, :, -1:, :]
        new_state = (jnp.exp(b_last[:, :, 0, :])[..., None] * state
                     + jnp.einsum('bhsk,bhsv->bhkv', kc * jnp.exp(b_last - b), vc))
        return new_state, o

    state0 = jnp.zeros((B, H, K, V), f32)
    _, o = lax.scan(step, state0, (qs, ks, vs, ls))
    o = o.transpose(1, 0, 3, 2, 4).reshape(B, S, H, V)
    o = rms_norm(o, g_out.reshape(H, V)) * jax.nn.sigmoid(go.astype(f32)).reshape(B, S, H, V)
    return o.reshape(B, S, H * V).astype(iv.dtype)


def short_conv_mix(bg, cg, xc, w_conv):
    z = cg * xc
    ch = z.shape[-1]
    y = lax.conv_general_dilated(z, w_conv[:, None, :].astype(z.dtype), window_strides=(1,),
                                 padding=[(CONV_K - 1, 0)],
                                 dimension_numbers=('NWC', 'WIO', 'NWC'),
                                 feature_group_count=ch)
    return bg * y


def spatial_gating_mix(u, v, ln_g, ln_b, w_s, b_s):
    B, S, _ = u.shape
    N = S // SG_CHUNK
    u = jax.nn.gelu(u)
    v = layer_norm(jax.nn.gelu(v), ln_g, ln_b)
    vg = v.reshape(B, N, SG_CHUNK, SG_GROUPS, SG_GROUP_DIM)
    mask = jnp.tril(jnp.ones((SG_CHUNK, SG_CHUNK), dtype=w_s.dtype))
    sv = jnp.einsum('gts,bnsgd->bntgd', w_s * mask, vg) + b_s.T[:, :, None]
    return u * sv.reshape(B, S, BRANCH_WIDTH)


def setup_inputs(seed: int = 0) -> dict:
    key = jax.random.key(seed)
    ks = jax.random.split(key, 17)
    W, D = BRANCH_WIDTH, D_MODEL
    nrm = jax.random.normal
    f32 = jnp.float32
    return {
        'x': nrm(ks[0], (BATCH, SEQ, D), f32),
        'w_in': nrm(ks[1], (DEPTH, D, IN_COLS), f32) * D ** -0.5,
        'g_mix': 1.0 + 0.01 * nrm(ks[2], (DEPTH, D), f32),
        'lower_bounds': 0.1 * nrm(ks[3], (DEPTH, W), f32),
        'g_hgrn_out': 1.0 + 0.01 * nrm(ks[4], (DEPTH, W), f32),
        'w_conv': nrm(ks[5], (DEPTH, CONV_K, W), f32) * CONV_K ** -0.5,
        'sg_ln_g': 1.0 + 0.01 * nrm(ks[6], (DEPTH, W), f32),
        'sg_ln_b': 0.01 * nrm(ks[7], (DEPTH, W), f32),
        'w_sg': nrm(ks[8], (DEPTH, SG_GROUPS, SG_CHUNK, SG_CHUNK), f32) * SG_CHUNK ** -0.5,
        'b_sg': 1.0 + 0.01 * nrm(ks[9], (DEPTH, SG_GROUPS, SG_CHUNK), f32),
        'w_branch': nrm(ks[10], (DEPTH, N_BRANCH, W, D), f32) * W ** -0.5,
        'w_o': nrm(ks[11], (DEPTH, D, D), f32) * D ** -0.5,
        'g_ffn': 1.0 + 0.01 * nrm(ks[12], (DEPTH, D), f32),
        'w_ff1': nrm(ks[13], (DEPTH, D, D_FF), f32) * D ** -0.5,
        'w_ff2': nrm(ks[14], (DEPTH, D_FF, D), f32) * D_FF ** -0.5,
        'g_final': 1.0 + 0.01 * nrm(ks[15], (D,), f32),
    }


def reference(x, w_in, g_mix, lower_bounds, g_hgrn_out, w_conv, sg_ln_g, sg_ln_b,
              w_sg, b_sg, w_branch, w_o, g_ffn, w_ff1, w_ff2, g_final):
    B, S, D = x.shape
    W = BRANCH_WIDTH
    lbs = jax.nn.softmax(lower_bounds.astype(jnp.float32), axis=0)
    lbs = jnp.cumsum(lbs, axis=0) - lbs[0]
    offsets = [W * i for i in range(1, 10)]
    for l in range(DEPTH):
        h = rms_norm(x, g_mix[l])
        p = h @ w_in[l]
        q, fp, iv, go, bg, cg, xc, u, v, gates = jnp.split(p, offsets, axis=-1)
        o_a = hgrn2_mix(q, fp, iv, go, lbs[l], g_hgrn_out[l])
        o_b = short_conv_mix(bg, cg, xc, w_conv[l])
        o_c = spatial_gating_mix(u, v, sg_ln_g[l], sg_ln_b[l], w_sg[l], b_sg[l])
        z = jnp.stack([o_a, o_b, o_c], axis=2)
        y = jnp.einsum('bsnw,nwd->bsnd', z, w_branch[l])
        gate = jax.nn.sigmoid(gates).reshape(B, S, N_BRANCH, D)
        merged = jnp.sum(gate * y, axis=2)
        x = x + merged @ w_o[l]
        h2 = rms_norm(x, g_ffn[l])
        x = x + jnp.square(jax.nn.relu(h2 @ w_ff1[l])) @ w_ff2[l]
    return rms_norm(x, g_final)
```

```cpp
#include <hip/hip_runtime.h>
#include <hip/hip_cooperative_groups.h>
#include <cstdio>
#include <cstdint>
namespace cg = cooperative_groups;

#ifndef MK_DBG_LAYERS
#define MK_DBG_LAYERS 4
#endif
#ifndef MK_DBG_PH
#define MK_DBG_PH 8
#endif
#ifndef MK_REP_B1
#define MK_REP_B1 1
#endif
#ifndef MK_REP_B2
#define MK_REP_B2 1
#endif
#ifndef MK_REP_B3
#define MK_REP_B3 1
#endif
#ifndef MK_REP_A
#define MK_REP_A 1
#endif
#ifndef MK_REP_C
#define MK_REP_C 1
#endif
#ifndef MK_REP_E
#define MK_REP_E 1
#endif
#ifndef MK_EXTRA_SYNC
#define MK_EXTRA_SYNC 0
#endif
#ifndef MK_REP_PRO
#define MK_REP_PRO 1
#endif
#ifndef MK_REP_D
#define MK_REP_D 1
#endif
#ifndef MK_REP_F
#define MK_REP_F 1
#endif

#define LAS __attribute__((address_space(3)))
typedef unsigned short bf16_t;
typedef short bf16x8 __attribute__((ext_vector_type(8)));
typedef float f32x4 __attribute__((ext_vector_type(4)));
typedef float f32x2 __attribute__((ext_vector_type(2)));
typedef unsigned u32x4 __attribute__((ext_vector_type(4)));
typedef unsigned u32x2 __attribute__((ext_vector_type(2)));

constexpr int T = 16384, D = 1024, BW = 512, NIN = 7680, FF = 4096, DEPTH = 4, SEQ = 2048;
constexpr int NP1 = 4608, NG = 3072;
constexpr float NORM_EPS = 1e-6f, LN_EPS = 1e-5f;
constexpr size_t MiB = 1u << 20;
constexpr size_t WS_LBS = 64 * 1024, WS_RSS = 128 * 1024, WS_DEC = 1280 * 1024;
constexpr size_t WS_WIN = 2 * MiB, WS_WBR = 62 * MiB, WS_WO = 74 * MiB, WS_W1 = 82 * MiB, WS_W2 = 114 * MiB;
constexpr size_t WS_XB = 146 * MiB, WS_ZA = 146 * MiB, WS_ZB = 162 * MiB, WS_ZC = 178 * MiB;
constexpr size_t WS_P1 = 194 * MiB, WS_H = 194 * MiB, WS_MS = 194 * MiB, WS_G = 338 * MiB, WS_MB = 434 * MiB, WS_ST = 434 * MiB, WS_SL = 146 * MiB, WS_END = 466 * MiB;
constexpr int LDS_BYTES = 147456;
constexpr int LDS_BARST = 147392;
constexpr size_t WS_BAR = 0, BAR_ZERO_BYTES = 16384;
constexpr int NPH = 2 + 8 * DEPTH;

typedef __bf16 bf16v2_t __attribute__((ext_vector_type(2)));
typedef _Float16 h16v2_t __attribute__((ext_vector_type(2)));
typedef _Float16 h16x8 __attribute__((ext_vector_type(8)));
__device__ __forceinline__ unsigned cvt_pk_truebf16(float lo, float hi) { bf16v2_t v; v.x = (__bf16)lo; v.y = (__bf16)hi; return __builtin_bit_cast(unsigned, v); }
__device__ __forceinline__ unsigned cvt_pk_h(float lo, float hi) { h16v2_t v; v.x = (_Float16)lo; v.y = (_Float16)hi; return __builtin_bit_cast(unsigned, v); }
__device__ __forceinline__ float h_lo(unsigned w) { return (float)__builtin_bit_cast(h16v2_t, w).x; }
__device__ __forceinline__ float h_hi(unsigned w) { return (float)__builtin_bit_cast(h16v2_t, w).y; }
#define MFMA_H(a, b, c) __builtin_amdgcn_mfma_f32_16x16x32_f16(__builtin_bit_cast(h16x8, (a)), __builtin_bit_cast(h16x8, (b)), (c), 0, 0, 0)
__device__ __forceinline__ float fast_sigmoid(float x) { return __builtin_amdgcn_rcpf(1.0f + __expf(-x)); }
#define DPP_ADD(v, ctrl) ((v) + __builtin_bit_cast(float, __builtin_amdgcn_update_dpp(0, __builtin_bit_cast(int, (v)), (ctrl), 0xf, 0xf, true)))
__device__ __forceinline__ float wave_sum(float v) {
    v = DPP_ADD(v, 0xB1); v = DPP_ADD(v, 0x4E); v = DPP_ADD(v, 0x124); v = DPP_ADD(v, 0x128);
    const int iv = __builtin_bit_cast(int, v);
    const float r0 = __builtin_bit_cast(float, __builtin_amdgcn_readlane(iv, 0)), r1 = __builtin_bit_cast(float, __builtin_amdgcn_readlane(iv, 16)), r2 = __builtin_bit_cast(float, __builtin_amdgcn_readlane(iv, 32)), r3 = __builtin_bit_cast(float, __builtin_amdgcn_readlane(iv, 48));
    return (r0 + r1) + (r2 + r3);
}
__device__ __forceinline__ float row_rs(const float* rss, int row) {
    const f32x4* p = (const f32x4*)(rss + (size_t)row * 16);
    const f32x4 a = p[0], b = p[1], c = p[2], d = p[3];
    const float s = ((a.x + a.y) + (a.z + a.w)) + ((b.x + b.y) + (b.z + b.w)) + ((c.x + c.y) + (c.z + c.w)) + ((d.x + d.y) + (d.z + d.w));
    return rsqrtf(s * (1.0f / D) + NORM_EPS);
}
__device__ __forceinline__ float row_rs4(const float* rss, int row, int fq) {
    const f32x4 a = *(const f32x4*)(rss + (size_t)row * 16 + 4 * fq);
    float s = (a.x + a.y) + (a.z + a.w);
    s += __shfl_xor(s, 16); s += __shfl_xor(s, 32);
    return rsqrtf(s * (1.0f / D) + NORM_EPS);
}

namespace pg8 {
constexpr int BM = 256, BK = 64, HALF = 128, HTB = HALF * BK * 2, STAGE_BYTES = 8 * HTB, NXCD = 8, WGM = 8;
__host__ __device__ __forceinline__ int lds_byte(int r, int c) { const int st = (r >> 4) * 2 + (c >> 5), rr = r & 15, cc = c & 31, ob = rr * 64 + cc * 2; return st * 1024 + (ob ^ (((ob >> 9) & 1) << 5)); }
__host__ __device__ __forceinline__ void stage_rc(int b, int& R, int& C) { const int st = b / 1024, sb = b % 1024, swz = sb ^ (((sb >> 9) & 1) << 5); R = (st >> 1) * 16 + swz / 64; C = (st & 1) * 32 + (swz % 64) / 2; }
__host__ __device__ __forceinline__ int perm32(int rho) { const int n = rho >> 4, i = rho & 15; return 8 * (i >> 2) + 4 * n + (i & 3); }

struct Unit { int pm, pn, br; };
__device__ __forceinline__ void tile_map(int wgid, int nM, int nN, int& pm, int& pn) {
    const int nwg = nM * nN;
    { const int q = nwg / NXCD, r = nwg % NXCD, xcd = wgid % NXCD, off = wgid / NXCD; wgid = (xcd < r ? xcd * (q + 1) : r * (q + 1) + (xcd - r) * q) + off; }
    const int nig = WGM * nN, gid = wgid / nig, fm = gid * WGM, gsz = (nM - fm) < WGM ? (nM - fm) : WGM;
    pm = fm + ((wgid % nig) % gsz); pn = (wgid % nig) / gsz;
}
struct StaticOrder {
    int nM, nN, nwg, G, c; const char* A; const char* Bt; size_t tstep;
    __device__ void init(const void* A_, const void* Bt_, int M, int N, int K, int G_, int c_) { nM = M / BM; nN = N / BM; nwg = nM * nN; G = G_; c = c_; A = (const char*)A_; Bt = (const char*)Bt_; tstep = (size_t)BM * K * 2; }
    __device__ __forceinline__ bool next(int i, Unit& u) const { const long L = (long)i * G + c; if (L >= nwg) return false; tile_map((int)L, nM, nN, u.pm, u.pn); u.br = 0; return true; }
    __device__ __forceinline__ const char* a_ptr(const Unit& u) const { return A + (size_t)u.pm * tstep; }
    __device__ __forceinline__ const char* b_ptr(const Unit& u) const { return Bt + (size_t)u.pn * tstep; }
};
struct BranchOrder {
    int nM, nN, nwg, G, c; const char* Z; const char* Wb; size_t tstep, zstride, wstride;
    __device__ void init(const void* Z_, size_t zstride_, const void* Wb_, int G_, int c_) { nM = T / BM; nN = D / BM; nwg = nM * nN; G = G_; c = c_; Z = (const char*)Z_; Wb = (const char*)Wb_; tstep = (size_t)BM * BW * 2; zstride = zstride_; wstride = (size_t)D * BW * 2; }
    __device__ __forceinline__ bool next(int i, Unit& u) const { const int r = i / 3; const long L = (long)r * G + c; if (L >= nwg) return false; tile_map((int)L, nM, nN, u.pm, u.pn); u.br = i - 3 * r; return true; }
    __device__ __forceinline__ const char* a_ptr(const Unit& u) const { return Z + (size_t)u.br * zstride + (size_t)u.pm * tstep; }
    __device__ __forceinline__ const char* b_ptr(const Unit& u) const { return Wb + (size_t)u.br * wstride + (size_t)u.pn * tstep; }
};

template <class Epi, class Sched>
__device__ __forceinline__ void gemm_phase(LAS unsigned char* lds, const int tid, const int K, const Sched& S, const Epi& E) {
    const int wid = __builtin_amdgcn_readfirstlane(tid >> 6), lane = tid & 63, wr = wid >> 2, wc = wid & 3, fr = lane & 15, fq = lane >> 4;
    const int nt = K / BK;
    unsigned voffA[2], voffB[2];
#pragma unroll
    for (int i = 0; i < 2; ++i) { int R, C; stage_rc(tid * 16 + i * 8192, R, C); const int Rb = (R & ~31) + perm32(R & 31);
        voffA[i] = (unsigned)(R * K + C) * 2u; voffB[i] = (unsigned)(Rb * K + C) * 2u; }
    const size_t kstep = (size_t)(BK * 2);
    const size_t hstep = (size_t)HALF * K * 2;
    const unsigned ldsw = (unsigned)wid * 1024u;
    const int aoff = lds_byte(wr * 64 + fr, fq * 8), boff = lds_byte(wc * 32 + fr, fq * 8);
#define PG8_SA(b, h) (((b) * 2 + (h)) * HTB)
#define PG8_SB(b, h) ((4 + (b) * 2 + (h)) * HTB)
#define PG8_STAGE(bufoff, gbase, voff) do { _Pragma("unroll") for (int _i = 0; _i < 2; ++_i) \
        __builtin_amdgcn_global_load_lds((const unsigned*)((const char*)(gbase) + (voff)[_i]), (LAS unsigned*)(lds + (bufoff) + ldsw + _i * 8192), 16, 0, 0); } while (0)
#define PG8_LDA(dst, b, h) do { _Pragma("unroll") for (int m = 0; m < 4; ++m) _Pragma("unroll") for (int k = 0; k < 2; ++k) dst[m][k] = *(const LAS bf16x8*)(lds + PG8_SA(b, h) + aoff + m * 2048 + k * 1024); } while (0)
#define PG8_LDB(dst, b, h) do { _Pragma("unroll") for (int n = 0; n < 2; ++n) _Pragma("unroll") for (int k = 0; k < 2; ++k) dst[n][k] = *(const LAS bf16x8*)(lds + PG8_SB(b, h) + boff + n * 2048 + k * 1024); } while (0)
#define PG8_MMA(ai, bj, At, Bt) do { __builtin_amdgcn_s_setprio(1); _Pragma("unroll") for (int m = 0; m < 4; ++m) _Pragma("unroll") for (int n = 0; n < 2; ++n) _Pragma("unroll") for (int k = 0; k < 2; ++k) \
        acc[ai][bj][m][n] = MFMA_H(Bt[n][k], At[m][k], acc[ai][bj][m][n]); __builtin_amdgcn_s_setprio(0); } while (0)
#define PG8_WAIT_V(n) asm volatile("s_waitcnt vmcnt(" #n ")" ::: "memory")
#define PG8_WAIT_L(n) asm volatile("s_waitcnt lgkmcnt(" #n ")" ::: "memory")
#define PG8_BAR __builtin_amdgcn_s_barrier()
#define PG8_SCHED __builtin_amdgcn_sched_barrier(0)
    Unit cur, nxt; int ui = 0;
    if (!S.next(0, cur)) return;
    f32x4 acc[2][2][4][2];
#pragma unroll
    for (int a = 0; a < 2; ++a)
#pragma unroll
        for (int b = 0; b < 2; ++b)
#pragma unroll
            for (int m = 0; m < 4; ++m)
#pragma unroll
                for (int n = 0; n < 2; ++n) acc[a][b][m][n] = (f32x4){0.f, 0.f, 0.f, 0.f};
    bf16x8 At[4][2], B0[2][2], B1[2][2];
    const char* cA = S.a_ptr(cur); const char* cB = S.b_ptr(cur);
    PG8_STAGE(PG8_SB(0, 0), cB, voffB); PG8_STAGE(PG8_SB(0, 1), cB + hstep, voffB); PG8_STAGE(PG8_SA(0, 0), cA, voffA); PG8_STAGE(PG8_SA(0, 1), cA + hstep, voffA);
    if (wr == 1) PG8_BAR;
    PG8_WAIT_V(2); PG8_BAR;
    PG8_STAGE(PG8_SB(1, 0), cB + kstep, voffB); PG8_STAGE(PG8_SA(1, 0), cA + kstep, voffA); PG8_STAGE(PG8_SB(1, 1), cB + hstep + kstep, voffB);
    PG8_WAIT_V(6); PG8_BAR;
    for (;;) {
        const bool has_next = S.next(ui + 1, nxt);
        const char* nA = has_next ? S.a_ptr(nxt) : cA; const char* nB = has_next ? S.b_ptr(nxt) : cB;
        for (int t = 0; t < nt; t += 2) {
            const bool last = (t == nt - 2);
            const char* a1 = cA + (size_t)(t + 1) * kstep;
            const char* a2 = last ? nA : cA + (size_t)(t + 2) * kstep; const char* b2 = last ? nB : cB + (size_t)(t + 2) * kstep;
            const char* a3 = a2 + kstep; const char* b3 = b2 + kstep;
            PG8_LDB(B0, 0, 0); PG8_LDB(B1, 0, 1); PG8_SCHED; PG8_LDA(At, 0, 0); PG8_STAGE(PG8_SA(1, 1), a1 + hstep, voffA);
            PG8_WAIT_V(8); PG8_WAIT_L(0); PG8_BAR; PG8_MMA(0, 0, At, B0); PG8_MMA(0, 1, At, B1); PG8_BAR; PG8_SCHED;
            PG8_LDA(At, 0, 1); PG8_STAGE(PG8_SB(0, 0), b2, voffB); PG8_STAGE(PG8_SB(0, 1), b2 + hstep, voffB); PG8_STAGE(PG8_SA(0, 0), a2, voffA);
            PG8_WAIT_V(8); PG8_WAIT_L(0); PG8_BAR; PG8_MMA(1, 0, At, B0); PG8_MMA(1, 1, At, B1); PG8_BAR; PG8_SCHED;
            PG8_LDB(B0, 1, 0); PG8_LDB(B1, 1, 1); PG8_SCHED; PG8_LDA(At, 1, 0); PG8_STAGE(PG8_SA(0, 1), a2 + hstep, voffA);
            PG8_WAIT_V(8); PG8_WAIT_L(0); PG8_BAR; PG8_MMA(0, 0, At, B0); PG8_MMA(0, 1, At, B1); PG8_BAR; PG8_SCHED;
            PG8_LDA(At, 1, 1); PG8_STAGE(PG8_SB(1, 0), b3, voffB); PG8_STAGE(PG8_SB(1, 1), b3 + hstep, voffB); PG8_STAGE(PG8_SA(1, 0), a3, voffA);
            PG8_WAIT_V(8); PG8_WAIT_L(0); PG8_BAR; PG8_MMA(1, 0, At, B0); PG8_MMA(1, 1, At, B1); PG8_BAR; PG8_SCHED;
        }
        if (wr == 0) PG8_BAR;
        E(acc, cur, wr, wc, fr, fq);
        if (!has_next) break;
        if (!(Epi::KEEPS && E.keep(cur))) {
#pragma unroll
        for (int a = 0; a < 2; ++a)
#pragma unroll
            for (int b = 0; b < 2; ++b)
#pragma unroll
                for (int m = 0; m < 4; ++m)
#pragma unroll
                    for (int n = 0; n < 2; ++n) acc[a][b][m][n] = (f32x4){0.f, 0.f, 0.f, 0.f};
        }
        cur = nxt; cA = nA; cB = nB; ++ui;
        if (wr == 1) PG8_BAR;
    }
    PG8_WAIT_V(0);
    PG8_BAR;
#undef PG8_SA
#undef PG8_SB
#undef PG8_STAGE
#undef PG8_LDA
#undef PG8_LDB
#undef PG8_MMA
#undef PG8_WAIT_V
#undef PG8_WAIT_L
#undef PG8_BAR
#undef PG8_SCHED
}

struct EpiA {
    static constexpr bool KEEPS = false;
    __device__ __forceinline__ bool keep(const Unit&) const { return false; }
    bf16_t* P1; bf16_t* G; const float* rss; const float* lbs_l;
    __device__ __forceinline__ void operator()(f32x4 (&acc)[2][2][4][2], const Unit& u, int wr, int wc, int fr, int fq) const {
        const int fn = u.pn >> 1;
        const int act = (fn == 0) ? 1 : ((fn == 3 || fn >= 9) ? 2 : ((fn == 7 || fn == 8) ? 3 : ((fn == 1) ? 4 : 0)));
        bf16_t* base; int ldc, colt;
        if (u.pn < 18) { base = P1; ldc = NP1; colt = u.pn * BM; } else { base = G; ldc = NG; colt = u.pn * BM - NP1; }
        const int row0 = u.pm * BM + wr * 64 + fr, col0 = colt + wc * 32 + 8 * fq;
        float lbv[2][8];
#pragma unroll
        for (int bj = 0; bj < 2; ++bj)
#pragma unroll
            for (int j = 0; j < 8; ++j) lbv[bj][j] = 0.f;
        if (act == 4) {
#pragma unroll
            for (int bj = 0; bj < 2; ++bj) { const f32x4 a = *(const f32x4*)(lbs_l + col0 - BW + bj * HALF), b = *(const f32x4*)(lbs_l + col0 - BW + bj * HALF + 4);
                lbv[bj][0] = a.x; lbv[bj][1] = a.y; lbv[bj][2] = a.z; lbv[bj][3] = a.w; lbv[bj][4] = b.x; lbv[bj][5] = b.y; lbv[bj][6] = b.z; lbv[bj][7] = b.w; } }
#pragma unroll
        for (int ai = 0; ai < 2; ++ai)
#pragma unroll
            for (int m = 0; m < 4; ++m) { const int row = row0 + ai * HALF + m * 16; const float rs = row_rs4(rss, row, fq);
                bf16_t* rowp = base + (size_t)row * ldc + col0;
#pragma unroll
                for (int bj = 0; bj < 2; ++bj) { float v[8];
#pragma unroll
                    for (int j = 0; j < 4; ++j) { v[j] = acc[ai][bj][m][0][j] * rs; v[4 + j] = acc[ai][bj][m][1][j] * rs; }
                    if (act == 2) {
#pragma unroll
                        for (int j = 0; j < 8; ++j) v[j] = __builtin_amdgcn_rcpf(1.0f + __builtin_amdgcn_exp2f(v[j] * -1.4426950409f));
                    } else if (act == 1) {
#pragma unroll
                        for (int j = 0; j < 8; ++j) v[j] = v[j] * __builtin_amdgcn_rcpf(1.0f + __builtin_amdgcn_exp2f(v[j] * -1.4426950409f));
                    } else if (act == 3) {
#pragma unroll
                        for (int j = 0; j < 8; ++j) { const float x = v[j], y = x * (-2.3022082f + -0.1029432f * x * x); v[j] = x * __builtin_amdgcn_rcpf(1.0f + __builtin_amdgcn_exp2f(y)); }
                    } else if (act == 4) {
#pragma unroll
                        for (int j = 0; j < 8; ++j) { const float x = fminf(fmaxf(v[j], -30.f), 30.f), s = __builtin_amdgcn_rcpf(1.0f + __builtin_amdgcn_exp2f(x * -1.4426950409f)); v[j] = lbv[bj][j] + (1.0f - lbv[bj][j]) * s; }
                    }
                    u32x4 w; w.x = cvt_pk_h(v[0], v[1]); w.y = cvt_pk_h(v[2], v[3]); w.z = cvt_pk_h(v[4], v[5]); w.w = cvt_pk_h(v[6], v[7]);
                    *(u32x4*)(rowp + bj * HALF) = w; } }
    }
};
struct EpiC {
    const bf16_t* G; bf16_t* MB;
    static constexpr bool KEEPS = true;
    __device__ __forceinline__ bool keep(const Unit& u) const { return u.br != 2; }
    __device__ __forceinline__ void operator()(f32x4 (&acc)[2][2][4][2], const Unit& u, int wr, int wc, int fr, int fq) const {
        const int row0 = u.pm * BM + wr * 64 + fr, col0 = u.pn * BM + wc * 32 + 8 * fq; const int br = u.br;
#pragma unroll
        for (int ai = 0; ai < 2; ++ai)
#pragma unroll
            for (int m = 0; m < 4; ++m) { const int row = row0 + ai * HALF + m * 16;
#pragma unroll
                for (int bj = 0; bj < 2; ++bj) { const int col = col0 + bj * HALF;
                    const u32x4 g = *(const u32x4*)(G + (size_t)row * NG + br * D + col);
                    f32x4 s0 = (f32x4){h_lo(g.x), h_hi(g.x), h_lo(g.y), h_hi(g.y)}, s1 = (f32x4){h_lo(g.z), h_hi(g.z), h_lo(g.w), h_hi(g.w)};
#pragma unroll
                    for (int j = 0; j < 4; ++j) { s0[j] = fmaxf(s0[j], 5.9604645e-8f); s1[j] = fmaxf(s1[j], 5.9604645e-8f); }
                    if (br != 2) { const u32x4 gn = *(const u32x4*)(G + (size_t)row * NG + (br + 1) * D + col);
                        const f32x4 d0 = (f32x4){h_lo(gn.x), h_hi(gn.x), h_lo(gn.y), h_hi(gn.y)}, d1 = (f32x4){h_lo(gn.z), h_hi(gn.z), h_lo(gn.w), h_hi(gn.w)};
#pragma unroll
                        for (int j = 0; j < 4; ++j) { s0[j] *= __builtin_amdgcn_rcpf(fmaxf(d0[j], 5.9604645e-8f)); s1[j] *= __builtin_amdgcn_rcpf(fmaxf(d1[j], 5.9604645e-8f)); }
                        acc[ai][bj][m][0] *= s0; acc[ai][bj][m][1] *= s1;
                    } else { const f32x4 v0 = acc[ai][bj][m][0] * s0, v1 = acc[ai][bj][m][1] * s1;
                        u32x4 w; w.x = cvt_pk_h(v0[0], v0[1]); w.y = cvt_pk_h(v0[2], v0[3]); w.z = cvt_pk_h(v1[0], v1[1]); w.w = cvt_pk_h(v1[2], v1[3]);
                        *(u32x4*)(MB + (size_t)row * D + col) = w; } } }
    }
};
struct EpiRes {
    static constexpr bool KEEPS = false;
    __device__ __forceinline__ bool keep(const Unit&) const { return false; }
    const float* Xin; float* X; bf16_t* XB; float* rss; int dummy;
    __device__ __forceinline__ void operator()(f32x4 (&acc)[2][2][4][2], const Unit& u, int wr, int wc, int fr, int fq) const {
        const int row0 = u.pm * BM + wr * 64 + fr, col0 = u.pn * BM + wc * 32 + 8 * fq;
#pragma unroll
        for (int ai = 0; ai < 2; ++ai)
#pragma unroll
            for (int m = 0; m < 4; ++m) { const int row = row0 + ai * HALF + m * 16; float ss = 0.f;
#pragma unroll
                for (int bj = 0; bj < 2; ++bj) { const int col = col0 + bj * HALF; float* xp = X + (size_t)row * D + col; const float* xi = Xin + (size_t)row * D + col;
                    const f32x4 x0 = *(const f32x4*)xi + acc[ai][bj][m][0], x1 = *(const f32x4*)(xi + 4) + acc[ai][bj][m][1];
                    if (!dummy) { *(f32x4*)xp = x0; *(f32x4*)(xp + 4) = x1; }
                    ss += (x0[0] * x0[0] + x0[1] * x0[1]) + (x0[2] * x0[2] + x0[3] * x0[3]) + (x1[0] * x1[0] + x1[1] * x1[1]) + (x1[2] * x1[2] + x1[3] * x1[3]);
                    u32x4 w; w.x = cvt_pk_h(x0[0], x0[1]); w.y = cvt_pk_h(x0[2], x0[3]); w.z = cvt_pk_h(x1[0], x1[1]); w.w = cvt_pk_h(x1[2], x1[3]);
                    if (!dummy || ss == 12345.678f) *(u32x4*)(XB + (size_t)row * D + col) = w; }
                ss += __shfl_xor(ss, 16); ss += __shfl_xor(ss, 32);
                if (fq == 0 && (!dummy || ss == 12345.678f)) rss[(size_t)row * 16 + u.pn * 4 + wc] = ss; }
    }
};
struct EpiE {
    static constexpr bool KEEPS = false;
    __device__ __forceinline__ bool keep(const Unit&) const { return false; }
    bf16_t* H; const float* rss;
    __device__ __forceinline__ void operator()(f32x4 (&acc)[2][2][4][2], const Unit& u, int wr, int wc, int fr, int fq) const {
        const int row0 = u.pm * BM + wr * 64 + fr, col0 = u.pn * BM + wc * 32 + 8 * fq;
#pragma unroll
        for (int ai = 0; ai < 2; ++ai)
#pragma unroll
            for (int m = 0; m < 4; ++m) { const int row = row0 + ai * HALF + m * 16; const float rs = row_rs4(rss, row, fq);
#pragma unroll
                for (int bj = 0; bj < 2; ++bj) { float v[8];
#pragma unroll
                    for (int j = 0; j < 4; ++j) { const float a = fmaxf(acc[ai][bj][m][0][j] * rs, 0.f), b = fmaxf(acc[ai][bj][m][1][j] * rs, 0.f); v[j] = a * a; v[4 + j] = b * b; }
                    u32x4 w; w.x = cvt_pk_h(v[0], v[1]); w.y = cvt_pk_h(v[2], v[3]); w.z = cvt_pk_h(v[4], v[5]); w.w = cvt_pk_h(v[6], v[7]);
                    *(u32x4*)(H + (size_t)row * FF + col0 + bj * HALF) = w; } }
    }
};
}

struct TDesc { const float* W; const float* gs; bf16_t* WT; int K, N, item; };
__device__ __forceinline__ void titem_load(const TDesc& d, f32x4 (&v)[16], int lane) {
    const int nblk = d.N / 64, kb = d.item / nblk, nb = d.item - kb * nblk, k0 = 64 * kb, n0 = 64 * nb;
    const int lr = lane >> 4, lc = (lane & 15) * 4;
#pragma unroll
    for (int i = 0; i < 16; ++i) v[i] = *(const f32x4*)(d.W + (size_t)(k0 + 4 * i + lr) * d.N + n0 + lc);
}
__device__ __forceinline__ void titem_finish(const TDesc& d, const f32x4 (&v)[16], LAS float* scr, int lane) {
    const int nblk = d.N / 64, kb = d.item / nblk, nb = d.item - kb * nblk, k0 = 64 * kb, n0 = 64 * nb;
    const int lr = lane >> 4, lc = (lane & 15) * 4;
#pragma unroll
    for (int i = 0; i < 16; ++i) { LAS float* p = scr + (4 * i + lr) * 65 + lc; p[0] = v[i].x; p[1] = v[i].y; p[2] = v[i].z; p[3] = v[i].w; }
    asm volatile("s_waitcnt lgkmcnt(0)" ::: "memory");
    const int c = lane & 7;
    f32x4 g0 = (f32x4){1.f, 1.f, 1.f, 1.f}, g1 = g0;
    if (d.gs) { g0 = *(const f32x4*)(d.gs + k0 + 8 * c); g1 = *(const f32x4*)(d.gs + k0 + 8 * c + 4); }
#pragma unroll
    for (int j = 0; j < 8; ++j) { const int n = (lane >> 3) + 8 * j; const LAS float* s = scr + (8 * c) * 65 + n;
        u32x4 o; o.x = cvt_pk_h(s[0 * 65] * g0.x, s[1 * 65] * g0.y); o.y = cvt_pk_h(s[2 * 65] * g0.z, s[3 * 65] * g0.w); o.z = cvt_pk_h(s[4 * 65] * g1.x, s[5 * 65] * g1.y); o.w = cvt_pk_h(s[6 * 65] * g1.z, s[7 * 65] * g1.w);
        *(u32x4*)(d.WT + (size_t)(n0 + n) * d.K + k0 + 8 * c) = o; }
    asm volatile("s_waitcnt lgkmcnt(0)" ::: "memory");
}
struct Args {
    const float* x; const float* w_in; const float* g_mix; const float* lower_bounds; const float* g_hgrn_out; const float* w_conv;
    const float* sg_ln_g; const float* sg_ln_b; const float* w_sg; const float* b_sg; const float* w_branch; const float* w_o;
    const float* g_ffn; const float* w_ff1; const float* w_ff2; const float* g_final;
    float* out; unsigned char* ws; int ph_lo, ph_hi;
};

__device__ __forceinline__ TDesc layer_item(const Args& a, unsigned char* ws, int l, int r) {
    constexpr int I_IN = (D / 64) * (NIN / 64), I_BR = (BW / 64) * (D / 64), I_O = (D / 64) * (D / 64), I_1 = (D / 64) * (FF / 64);
    TDesc d;
    if (r < I_IN) { d.W = a.w_in + (size_t)l * D * NIN; d.gs = a.g_mix + l * D; d.WT = (bf16_t*)(ws + WS_WIN) + (size_t)l * NIN * D; d.K = D; d.N = NIN; d.item = r; return d; } r -= I_IN;
    if (r < 3 * I_BR) { const int br = r / I_BR; d.W = a.w_branch + (size_t)(l * 3 + br) * BW * D; d.gs = nullptr; d.WT = (bf16_t*)(ws + WS_WBR) + (size_t)(l * 3 + br) * D * BW; d.K = BW; d.N = D; d.item = r - br * I_BR; return d; } r -= 3 * I_BR;
    if (r < I_O) { d.W = a.w_o + (size_t)l * D * D; d.gs = nullptr; d.WT = (bf16_t*)(ws + WS_WO) + (size_t)l * D * D; d.K = D; d.N = D; d.item = r; return d; } r -= I_O;
    if (r < I_1) { d.W = a.w_ff1 + (size_t)l * D * FF; d.gs = a.g_ffn + l * D; d.WT = (bf16_t*)(ws + WS_W1) + (size_t)l * FF * D; d.K = D; d.N = FF; d.item = r; return d; } r -= I_1;
    d.W = a.w_ff2 + (size_t)l * FF * D; d.gs = nullptr; d.WT = (bf16_t*)(ws + WS_W2) + (size_t)l * D * FF; d.K = FF; d.N = D; d.item = r; return d;
}
__device__ __forceinline__ void convert_layer(const Args& a, unsigned char* ws, int l, int worker, int nworkers, LAS float* scr, int lane) {
    constexpr int NITEMS = (D / 64) * (NIN / 64) + 3 * (BW / 64) * (D / 64) + (D / 64) * (D / 64) + (D / 64) * (FF / 64) + (FF / 64) * (D / 64);
    int it = worker; if (it >= NITEMS) return;
    TDesc dc = layer_item(a, ws, l, it); f32x4 vc[16]; titem_load(dc, vc, lane);
    for (;;) { const int nx = it + nworkers; const bool has = nx < NITEMS;
        TDesc dn = dc; f32x4 vn[16];
#pragma unroll
        for (int i = 0; i < 16; ++i) vn[i] = vc[i];
        if (has) { dn = layer_item(a, ws, l, nx); titem_load(dn, vn, lane); }
        titem_finish(dc, vc, scr, lane);
        if (!has) break;
        dc = dn; it = nx;
#pragma unroll
        for (int i = 0; i < 16; ++i) vc[i] = vn[i]; }
}

__device__ __forceinline__ void prologue(const Args& a, LAS unsigned char* lds, int wave, int lane, int vcu, int G) {
    unsigned char* ws = a.ws;
    LAS float* scr = (LAS float*)(lds + wave * 16640);
    const int gw = vcu * 8 + wave, NGW = G * 8;
    convert_layer(a, ws, 0, gw, NGW, scr, lane);
    bf16_t* XB = (bf16_t*)(ws + WS_XB); float* rss = (float*)(ws + WS_RSS);
    for (int m = gw; m < T; m += NGW) {
        const f32x4* xr = (const f32x4*)(a.x + (size_t)m * D) + lane; u32x2* bo = (u32x2*)(XB + (size_t)m * D) + lane;
        float s = 0.f;
#pragma unroll
        for (int j = 0; j < 4; ++j) { const f32x4 v = xr[64 * j]; s += (v.x * v.x + v.y * v.y) + (v.z * v.z + v.w * v.w);
            u32x2 w; w.x = cvt_pk_h(v.x, v.y); w.y = cvt_pk_h(v.z, v.w); bo[64 * j] = w; }
        s = wave_sum(s);
        if (lane < 16) rss[(size_t)m * 16 + lane] = (lane == 0) ? s : 0.f;
    }
    if (vcu == 0) { const int w = wave * 64 + lane; float* lbs = (float*)(ws + WS_LBS);
        float v[DEPTH]; float mx = -1e30f;
#pragma unroll
        for (int i = 0; i < DEPTH; ++i) { v[i] = a.lower_bounds[i * BW + w]; mx = fmaxf(mx, v[i]); }
        float sum = 0.f;
#pragma unroll
        for (int i = 0; i < DEPTH; ++i) { v[i] = __expf(v[i] - mx); sum += v[i]; }
        float cum = 0.f; const float inv = 1.0f / sum;
#pragma unroll
        for (int i = 0; i < DEPTH; ++i) { if (i > 0) cum += v[i] * inv; lbs[i * BW + w] = cum; }
    }
}

__device__ __forceinline__ void unpack8(const u32x4 w, float (&f)[8]) { f[0] = h_lo(w.x); f[1] = h_hi(w.x); f[2] = h_lo(w.y); f[3] = h_hi(w.y); f[4] = h_lo(w.z); f[5] = h_hi(w.z); f[6] = h_lo(w.w); f[7] = h_hi(w.w); }
__device__ __forceinline__ u32x4 pack8(const float (&f)[8]) { u32x4 w; w.x = cvt_pk_h(f[0], f[1]); w.y = cvt_pk_h(f[2], f[3]); w.z = cvt_pk_h(f[4], f[5]); w.w = cvt_pk_h(f[6], f[7]); return w; }
__device__ __forceinline__ u32x4 pack8_truebf16(const float (&f)[8]) { u32x4 w; w.x = cvt_pk_truebf16(f[0], f[1]); w.y = cvt_pk_truebf16(f[2], f[3]); w.z = cvt_pk_truebf16(f[4], f[5]); w.w = cvt_pk_truebf16(f[6], f[7]); return w; }
__device__ __forceinline__ unsigned short bf16_of(float f) { return (unsigned short)(cvt_pk_h(f, 0.f) & 0xffffu); }

constexpr int HL_BL = 0;
constexpr int HL_SEG = 32768;
constexpr int HL_A1 = 34816;
constexpr int HL_BK = HL_A1 + 17408;
constexpr int HL_QH = HL_BK + 17408;
constexpr int HL_VT = HL_QH + 17408;
constexpr int HL_P = HL_VT + 18432;
constexpr int HL_RS = HL_P + 9216;
constexpr int HL_KT = HL_A1;
static_assert(HL_RS + 512 <= LDS_BYTES, "hgrn lds");

struct HPre { u32x4 f[2], iv[2]; };
template <bool WANT_Q> __device__ __forceinline__ void hgrn_load(HPre& p, const bf16_t* P1, int unit, int tid) {
    const int bh = unit >> 5, c = unit & 31, t0 = (bh >> 2) * SEQ + c * 64, ch0 = (bh & 3) * 128, c8 = tid & 15;
#pragma unroll
    for (int j = 0; j < 2; ++j) { const bf16_t* rp = P1 + (size_t)(t0 + (tid >> 4) + 32 * j) * NP1 + ch0 + 8 * c8;
        p.f[j] = *(const u32x4*)(rp + BW); p.iv[j] = *(const u32x4*)(rp + 2 * BW); }
}
__device__ __forceinline__ void hgrn_prep(const HPre& pre, LAS unsigned char* lds, int tid, float (&kk)[2][8]) {
    LAS float* BL = (LAS float*)(lds + HL_BL); LAS float* SEG = (LAS float*)(lds + HL_SEG);
    const int c8 = tid & 15;
#pragma unroll
    for (int j = 0; j < 2; ++j) { const int r = (tid >> 4) + 32 * j;
        float f[8]; unpack8(pre.f[j], f);
        float lf[8];
#pragma unroll
        for (int e = 0; e < 8; ++e) { lf[e] = __logf(fmaxf(f[e], 5.9604645e-8f)); kk[j][e] = 1.0f - f[e]; }
        *(LAS f32x4*)(BL + r * 128 + 8 * c8) = (f32x4){lf[0], lf[1], lf[2], lf[3]}; *(LAS f32x4*)(BL + r * 128 + 8 * c8 + 4) = (f32x4){lf[4], lf[5], lf[6], lf[7]}; }
    __syncthreads();
    { const int ch = tid & 127, seg = tid >> 7; float v[16]; float run = 0.f;
#pragma unroll
      for (int j = 0; j < 16; ++j) { run += BL[(seg * 16 + j) * 128 + ch]; v[j] = run; }
      SEG[seg * 128 + ch] = run;
      __syncthreads();
      float pre = 0.f;
#pragma unroll
      for (int s = 0; s < 3; ++s) { const float tot = SEG[s * 128 + ch]; if (s < seg) pre += tot; }
#pragma unroll
      for (int j = 0; j < 16; ++j) BL[(seg * 16 + j) * 128 + ch] = v[j] + pre; }
    __syncthreads();
}

__device__ __forceinline__ void hgrn_pass1(const bf16_t* P1, HPre& pre, int next_unit, bf16_t* ST, float* DEC, LAS unsigned char* lds, int unit, int tid, int wave, int lane) {
    const int bh = unit >> 5, c = unit & 31, b = bh >> 2, h = bh & 3, t0 = b * SEQ + c * 64, ch0 = h * 128;
    float kk[2][8];
    __syncthreads();
    hgrn_prep(pre, lds, tid, kk);
    LAS float* BL = (LAS float*)(lds + HL_BL);
    LAS unsigned short* KT = (LAS unsigned short*)(lds + HL_KT); LAS unsigned short* VT = (LAS unsigned short*)(lds + HL_VT);
    const int c8 = tid & 15;
    float bl[8];
    { const f32x4 a = *(const LAS f32x4*)(BL + 63 * 128 + 8 * c8), bq = *(const LAS f32x4*)(BL + 63 * 128 + 8 * c8 + 4); bl[0] = a.x; bl[1] = a.y; bl[2] = a.z; bl[3] = a.w; bl[4] = bq.x; bl[5] = bq.y; bl[6] = bq.z; bl[7] = bq.w; }
#pragma unroll
    for (int j = 0; j < 2; ++j) { const int r = (tid >> 4) + 32 * j;
        const f32x4 b0 = *(const LAS f32x4*)(BL + r * 128 + 8 * c8), b1 = *(const LAS f32x4*)(BL + r * 128 + 8 * c8 + 4);
        const float B[8] = {b0.x, b0.y, b0.z, b0.w, b1.x, b1.y, b1.z, b1.w};
        float iv[8]; unpack8(pre.iv[j], iv);
#pragma unroll
        for (int e = 0; e < 8; ++e) { KT[(8 * c8 + e) * 72 + r] = bf16_of(kk[j][e] * __expf(bl[e] - B[e])); VT[(8 * c8 + e) * 72 + r] = bf16_of(iv[e]); } }
    if (tid < 128) DEC[(size_t)unit * 128 + tid] = __expf(BL[63 * 128 + tid]);
    if (next_unit < 1024) hgrn_load<false>(pre, P1, next_unit, tid);
    __syncthreads();
    const int l16 = lane & 15, lq = lane >> 4;
    bf16x8 af[2];
#pragma unroll
    for (int ks = 0; ks < 2; ++ks) af[ks] = *(const LAS bf16x8*)(lds + HL_KT + (wave * 16 + l16) * 144 + (ks * 32 + 8 * lq) * 2);
#pragma unroll
    for (int vt = 0; vt < 8; ++vt) { f32x4 acc = (f32x4){0.f, 0.f, 0.f, 0.f};
#pragma unroll
        for (int ks = 0; ks < 2; ++ks) { const bf16x8 bfr = *(const LAS bf16x8*)(lds + HL_VT + (vt * 16 + l16) * 144 + (ks * 32 + 8 * lq) * 2);
            acc = MFMA_H(af[ks], bfr, acc); }
        u32x2 w; w.x = cvt_pk_h(acc[0], acc[1]); w.y = cvt_pk_h(acc[2], acc[3]);
        *(u32x2*)(ST + ((size_t)unit * 128 + vt * 16 + l16) * 128 + wave * 16 + 4 * lq) = w; }
}

constexpr int P1_SUB = 71680, P1_BL = 0, P1_SEG = 32768, P1_KT = 34816, P1_VT = 53248;
static_assert(2 * P1_SUB <= LDS_BARST, "paired pass-1 LDS");
__device__ __forceinline__ void hgrn_pass1_pair(const bf16_t* P1, HPre (&pre)[2], int nu0, int nu1, bf16_t* ST, float* DEC, LAS unsigned char* lds, int u0, int u1, int tid, int wave, int lane) {
    const int c8 = tid & 15, ch = tid & 127, seg = tid >> 7;
    float kk[2][2][8]; float sv[2][16];
    __syncthreads();
#pragma unroll
    for (int s = 0; s < 2; ++s) { LAS float* BL = (LAS float*)(lds + s * P1_SUB + P1_BL);
#pragma unroll
        for (int j = 0; j < 2; ++j) { const int r = (tid >> 4) + 32 * j;
            float f[8]; unpack8(pre[s].f[j], f); float lf[8];
#pragma unroll
            for (int e = 0; e < 8; ++e) { lf[e] = __logf(fmaxf(f[e], 5.9604645e-8f)); kk[s][j][e] = 1.0f - f[e]; }
            *(LAS f32x4*)(BL + r * 128 + 8 * c8) = (f32x4){lf[0], lf[1], lf[2], lf[3]}; *(LAS f32x4*)(BL + r * 128 + 8 * c8 + 4) = (f32x4){lf[4], lf[5], lf[6], lf[7]}; } }
    __syncthreads();
#pragma unroll
    for (int s = 0; s < 2; ++s) { LAS float* BL = (LAS float*)(lds + s * P1_SUB + P1_BL); LAS float* SEG = (LAS float*)(lds + s * P1_SUB + P1_SEG); float run = 0.f;
#pragma unroll
        for (int j = 0; j < 16; ++j) { run += BL[(seg * 16 + j) * 128 + ch]; sv[s][j] = run; }
        SEG[seg * 128 + ch] = run; }
    __syncthreads();
#pragma unroll
    for (int s = 0; s < 2; ++s) { LAS float* BL = (LAS float*)(lds + s * P1_SUB + P1_BL); LAS float* SEG = (LAS float*)(lds + s * P1_SUB + P1_SEG); float pre_ = 0.f;
#pragma unroll
        for (int q = 0; q < 3; ++q) { const float tot = SEG[q * 128 + ch]; if (q < seg) pre_ += tot; }
#pragma unroll
        for (int j = 0; j < 16; ++j) BL[(seg * 16 + j) * 128 + ch] = sv[s][j] + pre_; }
    __syncthreads();
#pragma unroll
    for (int s = 0; s < 2; ++s) { const int unit = s ? u1 : u0;
        LAS float* BL = (LAS float*)(lds + s * P1_SUB + P1_BL);
        LAS unsigned short* KT = (LAS unsigned short*)(lds + s * P1_SUB + P1_KT); LAS unsigned short* VT = (LAS unsigned short*)(lds + s * P1_SUB + P1_VT);
        float bl[8];
        { const f32x4 a = *(const LAS f32x4*)(BL + 63 * 128 + 8 * c8), bq = *(const LAS f32x4*)(BL + 63 * 128 + 8 * c8 + 4); bl[0] = a.x; bl[1] = a.y; bl[2] = a.z; bl[3] = a.w; bl[4] = bq.x; bl[5] = bq.y; bl[6] = bq.z; bl[7] = bq.w; }
#pragma unroll
        for (int j = 0; j < 2; ++j) { const int r = (tid >> 4) + 32 * j;
            const f32x4 b0 = *(const LAS f32x4*)(BL + r * 128 + 8 * c8), b1 = *(const LAS f32x4*)(BL + r * 128 + 8 * c8 + 4);
            const float B[8] = {b0.x, b0.y, b0.z, b0.w, b1.x, b1.y, b1.z, b1.w};
            float iv[8]; unpack8(pre[s].iv[j], iv);
#pragma unroll
            for (int e = 0; e < 8; ++e) { KT[(8 * c8 + e) * 72 + r] = bf16_of(kk[s][j][e] * __expf(bl[e] - B[e])); VT[(8 * c8 + e) * 72 + r] = bf16_of(iv[e]); } }
        if (tid < 128) DEC[(size_t)unit * 128 + tid] = __expf(BL[63 * 128 + tid]); }
    if (nu0 < 1024) hgrn_load<false>(pre[0], P1, nu0, tid);
    if (nu1 < 1024) hgrn_load<false>(pre[1], P1, nu1, tid);
    __syncthreads();
    const int l16 = lane & 15, lq = lane >> 4;
#pragma unroll
    for (int s = 0; s < 2; ++s) { const int unit = s ? u1 : u0;
        bf16x8 af[2];
#pragma unroll
        for (int ks = 0; ks < 2; ++ks) af[ks] = *(const LAS bf16x8*)(lds + s * P1_SUB + P1_KT + (wave * 16 + l16) * 144 + (ks * 32 + 8 * lq) * 2);
#pragma unroll
        for (int vt = 0; vt < 8; ++vt) { f32x4 acc = (f32x4){0.f, 0.f, 0.f, 0.f};
#pragma unroll
            for (int ks = 0; ks < 2; ++ks) { const bf16x8 bfr = *(const LAS bf16x8*)(lds + s * P1_SUB + P1_VT + (vt * 16 + l16) * 144 + (ks * 32 + 8 * lq) * 2);
                acc = MFMA_H(af[ks], bfr, acc); }
            u32x2 w; w.x = cvt_pk_h(acc[0], acc[1]); w.y = cvt_pk_h(acc[2], acc[3]);
            *(u32x2*)(ST + ((size_t)unit * 128 + vt * 16 + l16) * 128 + wave * 16 + 4 * lq) = w; } }
}

__device__ __forceinline__ void hgrn_pass3(const bf16_t* P1, HPre& pre, int next_unit, const bf16_t* ST, const float* gout_l, bf16_t* ZA, LAS unsigned char* lds, int unit, int tid, int wave, int lane) {
    const int bh = unit >> 5, c = unit & 31, b = bh >> 2, h = bh & 3, t0 = b * SEQ + c * 64, ch0 = h * 128;
    float kk[2][8];
    __syncthreads();
    hgrn_prep(pre, lds, tid, kk);
    LAS float* BL = (LAS float*)(lds + HL_BL);
    LAS unsigned short* VT = (LAS unsigned short*)(lds + HL_VT);
    const int c8 = tid & 15;
    float rf[8];
    { const f32x4 a = *(const LAS f32x4*)(BL + 31 * 128 + 8 * c8), bq = *(const LAS f32x4*)(BL + 31 * 128 + 8 * c8 + 4); rf[0] = a.x; rf[1] = a.y; rf[2] = a.z; rf[3] = a.w; rf[4] = bq.x; rf[5] = bq.y; rf[6] = bq.z; rf[7] = bq.w; }
#pragma unroll
    for (int j = 0; j < 2; ++j) { const int r = (tid >> 4) + 32 * j;
        const f32x4 b0 = *(const LAS f32x4*)(BL + r * 128 + 8 * c8), b1 = *(const LAS f32x4*)(BL + r * 128 + 8 * c8 + 4);
        const float B[8] = {b0.x, b0.y, b0.z, b0.w, b1.x, b1.y, b1.z, b1.w};
        float q[8]; unpack8(*(const u32x4*)(P1 + (size_t)(t0 + r) * NP1 + ch0 + 8 * c8), q);
        float iv[8]; unpack8(pre.iv[j], iv);
        float a1[8], bk[8], qh[8];
#pragma unroll
        for (int e = 0; e < 8; ++e) { const float d = B[e] - rf[e]; a1[e] = q[e] * __expf(fminf(d, 80.f)); bk[e] = kk[j][e] * __expf(fminf(-d, 80.f)); qh[e] = q[e] * __expf(B[e]); VT[(8 * c8 + e) * 72 + r] = bf16_of(iv[e]); }
        *(LAS u32x4*)(lds + HL_A1 + r * 272 + 16 * c8) = pack8_truebf16(a1);
        *(LAS u32x4*)(lds + HL_BK + r * 272 + 16 * c8) = pack8_truebf16(bk);
        *(LAS u32x4*)(lds + HL_QH + r * 272 + 16 * c8) = pack8(qh); }
    if (next_unit < 1024) hgrn_load<true>(pre, P1, next_unit, tid);
    const int l16 = lane & 15, lq = lane >> 4;
    bf16x8 sf[4][4]; u32x2 gov[4];
    { const int vh_ = wave >> 2, ti_ = wave & 3;
#pragma unroll
      for (int jv = 0; jv < 4; ++jv) { const bf16_t* sp = ST + ((size_t)unit * 128 + (vh_ * 4 + jv) * 16 + l16) * 128 + 8 * lq;
#pragma unroll
          for (int k4 = 0; k4 < 4; ++k4) sf[jv][k4] = *(const bf16x8*)(sp + k4 * 32);
          gov[jv] = *(const u32x2*)(P1 + (size_t)(t0 + ti_ * 16 + l16) * NP1 + 3 * BW + ch0 + (vh_ * 4 + jv) * 16 + 4 * lq); } }
    __syncthreads();
#pragma unroll
    for (int j = 0; j < 2; ++j) { const int id = 2 * wave + j, si = id >> 2, ti = id & 3; f32x4 acc = (f32x4){0.f, 0.f, 0.f, 0.f};
#pragma unroll
        for (int k4 = 0; k4 < 4; ++k4) { const bf16x8 af = *(const LAS bf16x8*)(lds + HL_BK + (si * 16 + l16) * 272 + (k4 * 32 + 8 * lq) * 2);
            const bf16x8 bfr = *(const LAS bf16x8*)(lds + HL_A1 + (ti * 16 + l16) * 272 + (k4 * 32 + 8 * lq) * 2);
            acc = __builtin_amdgcn_mfma_f32_16x16x32_bf16(af, bfr, acc, 0, 0, 0); }
#pragma unroll
        for (int r = 0; r < 4; ++r) { const bool keep = (si < ti) || (si == ti && 4 * lq + r <= l16); acc[r] = keep ? acc[r] : 0.f; }
        u32x2 w; w.x = cvt_pk_h(acc[0], acc[1]); w.y = cvt_pk_h(acc[2], acc[3]);
        *(LAS u32x2*)(lds + HL_P + (ti * 16 + l16) * 144 + (si * 16 + 4 * lq) * 2) = w; }
    __syncthreads();
    const int ti = wave & 3, vh = wave >> 2;
    f32x4 o[4]; float ss = 0.f;
    bf16x8 pf[2], qf[4];
#pragma unroll
    for (int ks = 0; ks < 2; ++ks) pf[ks] = *(const LAS bf16x8*)(lds + HL_P + (ti * 16 + l16) * 144 + (ks * 32 + 8 * lq) * 2);
#pragma unroll
    for (int k4 = 0; k4 < 4; ++k4) qf[k4] = *(const LAS bf16x8*)(lds + HL_QH + (ti * 16 + l16) * 272 + (k4 * 32 + 8 * lq) * 2);
#pragma unroll
    for (int jv = 0; jv < 4; ++jv) { const int vt = vh * 4 + jv; f32x4 acc = (f32x4){0.f, 0.f, 0.f, 0.f};
#pragma unroll
        for (int ks = 0; ks < 2; ++ks) { const bf16x8 af = *(const LAS bf16x8*)(lds + HL_VT + (vt * 16 + l16) * 144 + (ks * 32 + 8 * lq) * 2);
            acc = MFMA_H(af, pf[ks], acc); }
#pragma unroll
        for (int k4 = 0; k4 < 4; ++k4) acc = MFMA_H(sf[jv][k4], qf[k4], acc);
        o[jv] = acc; ss += (acc[0] * acc[0] + acc[1] * acc[1]) + (acc[2] * acc[2] + acc[3] * acc[3]); }
    ss += __shfl_xor(ss, 16); ss += __shfl_xor(ss, 32);
    LAS float* RS = (LAS float*)(lds + HL_RS);
    if (lq == 0) RS[vh * 64 + ti * 16 + l16] = ss;
    __syncthreads();
    const float rstd = rsqrtf((RS[ti * 16 + l16] + RS[64 + ti * 16 + l16]) * (1.0f / 128.0f) + NORM_EPS);
    const int trow = t0 + ti * 16 + l16;
#pragma unroll
    for (int jv = 0; jv < 4; ++jv) { const int v = (vh * 4 + jv) * 16 + 4 * lq;
        const f32x4 g4 = *(const f32x4*)(gout_l + ch0 + v);
        const u32x2 go = gov[jv];
        const f32x4 r = o[jv] * rstd * g4 * (f32x4){h_lo(go.x), h_hi(go.x), h_lo(go.y), h_hi(go.y)};
        u32x2 w; w.x = cvt_pk_h(r[0], r[1]); w.y = cvt_pk_h(r[2], r[3]);
        *(u32x2*)(ZA + (size_t)trow * BW + ch0 + v) = w; }
}

__device__ __forceinline__ void hgrn_scan(const bf16_t* SL, bf16_t* ST, const float* DEC, int gtid, int nthreads) {
    for (int it = gtid; it < 32 * 128 * 32; it += nthreads) {
        const int bh = it >> 12, rem = it & 4095, v = rem >> 5, k4 = (rem & 31) * 4;
        const bf16_t* lp = SL + ((size_t)(bh * 32) * 128 + v) * 128 + k4; bf16_t* sp = ST + ((size_t)(bh * 32) * 128 + v) * 128 + k4; const float* dp = DEC + (size_t)(bh * 32) * 128 + k4;
        u32x2 Lv[32];
#pragma unroll
        for (int c = 0; c < 32; ++c) Lv[c] = *(const u32x2*)(lp + (size_t)c * 128 * 128);
        f32x4 S = (f32x4){0.f, 0.f, 0.f, 0.f};
#pragma unroll
        for (int c0 = 0; c0 < 32; c0 += 8) { f32x4 dv[8];
#pragma unroll
            for (int j = 0; j < 8; ++j) dv[j] = *(const f32x4*)(dp + (size_t)(c0 + j) * 128);
#pragma unroll
            for (int j = 0; j < 8; ++j) { u32x2 w; w.x = cvt_pk_h(S[0], S[1]); w.y = cvt_pk_h(S[2], S[3]);
                *(u32x2*)(sp + (size_t)(c0 + j) * 128 * 128) = w;
                S = dv[j] * S + (f32x4){h_lo(Lv[c0 + j].x), h_hi(Lv[c0 + j].x), h_lo(Lv[c0 + j].y), h_hi(Lv[c0 + j].y)}; } }
    }
}

__device__ __forceinline__ void conv_phase(const bf16_t* P1, const float* wconv_l, bf16_t* ZB, int gtid, int nthreads) {
    for (int it = gtid; it < (T / 4) * 64; it += nthreads) {
        const int c8 = it & 63, t = (it >> 6) * 4; const bool head = ((t & (SEQ - 1)) == 0);
        u32x4 cgr[6], xcr[6], bgr[4];
#pragma unroll
        for (int i = 0; i < 6; ++i) { const int row = (i < 2 && head) ? t : (t - 2 + i); const bf16_t* rp = P1 + (size_t)row * NP1 + 8 * c8; cgr[i] = *(const u32x4*)(rp + 5 * BW); xcr[i] = *(const u32x4*)(rp + 6 * BW); }
#pragma unroll
        for (int o = 0; o < 4; ++o) bgr[o] = *(const u32x4*)(P1 + (size_t)(t + o) * NP1 + 4 * BW + 8 * c8);
        float wc[3][8];
#pragma unroll
        for (int j = 0; j < 3; ++j) { const f32x4 a = *(const f32x4*)(wconv_l + j * BW + 8 * c8), bq = *(const f32x4*)(wconv_l + j * BW + 8 * c8 + 4);
            wc[j][0] = a.x; wc[j][1] = a.y; wc[j][2] = a.z; wc[j][3] = a.w; wc[j][4] = bq.x; wc[j][5] = bq.y; wc[j][6] = bq.z; wc[j][7] = bq.w; }
        float z[6][8];
#pragma unroll
        for (int i = 0; i < 6; ++i) { float cgv[8], xcv[8]; unpack8(cgr[i], cgv); unpack8(xcr[i], xcv); const bool zero = (i < 2 && head);
#pragma unroll
            for (int e = 0; e < 8; ++e) z[i][e] = zero ? 0.f : cgv[e] * xcv[e]; }
#pragma unroll
        for (int o = 0; o < 4; ++o) { float bg[8]; unpack8(bgr[o], bg); float y[8];
#pragma unroll
            for (int e = 0; e < 8; ++e) y[e] = bg[e] * (wc[0][e] * z[o][e] + wc[1][e] * z[o + 1][e] + wc[2][e] * z[o + 2][e]);
            *(u32x4*)(ZB + (size_t)(t + o) * BW + 8 * c8) = pack8(y); }
    }
}

constexpr int SG_VT = 0;
__device__ __forceinline__ void sg_unit(const bf16_t* P1, const float* lng, const float* lnb, const float* wsg_l, const float* bsg_l, bf16_t* ZC, LAS unsigned char* lds, int unit, int wave, int lane) {
    const int ci = unit >> 2, g = unit & 3, t0 = ci * 128;
    LAS unsigned short* VT = (LAS unsigned short*)(lds + SG_VT);
    __syncthreads();
    const bool mine = ((lane >> 4) == g); const int d0 = (lane & 15) * 8;
    float lg[8], lb[8];
    { const f32x4 a = *(const f32x4*)(lng + g * 128 + d0), bq = *(const f32x4*)(lng + g * 128 + d0 + 4), cq = *(const f32x4*)(lnb + g * 128 + d0), dq = *(const f32x4*)(lnb + g * 128 + d0 + 4);
      lg[0] = a.x; lg[1] = a.y; lg[2] = a.z; lg[3] = a.w; lg[4] = bq.x; lg[5] = bq.y; lg[6] = bq.z; lg[7] = bq.w; lb[0] = cq.x; lb[1] = cq.y; lb[2] = cq.z; lb[3] = cq.w; lb[4] = dq.x; lb[5] = dq.y; lb[6] = dq.z; lb[7] = dq.w; }
    const int l16 = lane & 15, lq = lane >> 4, t = wave * 16 + l16, nk = (wave >> 1) + 1;
    f32x4 wraw[4][2]; u32x2 uu8[8];
    { const float* wrow = wsg_l + ((size_t)g * 128 + t) * 128 + 8 * lq;
#pragma unroll
      for (int k4 = 0; k4 < 4; ++k4) { if (k4 < nk) { wraw[k4][0] = *(const f32x4*)(wrow + k4 * 32); wraw[k4][1] = *(const f32x4*)(wrow + k4 * 32 + 4); } else { wraw[k4][0] = (f32x4){0.f, 0.f, 0.f, 0.f}; wraw[k4][1] = wraw[k4][0]; } }
#pragma unroll
      for (int jd = 0; jd < 8; ++jd) uu8[jd] = *(const u32x2*)(P1 + (size_t)(t0 + t) * NP1 + 7 * BW + g * 128 + jd * 16 + 4 * lq); }
    const float bs = bsg_l[g * 128 + t];
    u32x4 xr[16];
#pragma unroll
    for (int i = 0; i < 16; ++i) xr[i] = *(const u32x4*)(P1 + (size_t)(t0 + wave + 8 * i) * NP1 + 8 * BW + 8 * lane);
#pragma unroll
    for (int i = 0; i < 16; ++i) { const int r = wave + 8 * i;
        float x[8]; unpack8(xr[i], x);
        float s = ((x[0] + x[1]) + (x[2] + x[3])) + ((x[4] + x[5]) + (x[6] + x[7]));
        const float mean = wave_sum(s) * (1.0f / BW); float q = 0.f;
#pragma unroll
        for (int e = 0; e < 8; ++e) { x[e] -= mean; q += x[e] * x[e]; }
        const float rstd = rsqrtf(wave_sum(q) * (1.0f / BW) + LN_EPS);
        if (mine) {
#pragma unroll
            for (int e = 0; e < 8; ++e) VT[(d0 + e) * 136 + r] = bf16_of(x[e] * rstd * lg[e] + lb[e]); } }
    __syncthreads();
    bf16x8 wf[4];
#pragma unroll
    for (int k4 = 0; k4 < 4; ++k4) { float w[8] = {wraw[k4][0].x, wraw[k4][0].y, wraw[k4][0].z, wraw[k4][0].w, wraw[k4][1].x, wraw[k4][1].y, wraw[k4][1].z, wraw[k4][1].w};
#pragma unroll
        for (int e = 0; e < 8; ++e) w[e] = (k4 * 32 + 8 * lq + e <= t) ? w[e] : 0.f;
        const u32x4 pk = pack8(w); wf[k4] = __builtin_bit_cast(bf16x8, pk); }
#pragma unroll
    for (int jd = 0; jd < 8; ++jd) { f32x4 acc = (f32x4){0.f, 0.f, 0.f, 0.f};
#pragma unroll
        for (int k4 = 0; k4 < 4; ++k4) { const bf16x8 af = *(const LAS bf16x8*)(lds + SG_VT + (jd * 16 + l16) * 272 + (k4 * 32 + 8 * lq) * 2);
            acc = MFMA_H(af, wf[k4], acc); }
        const int d = jd * 16 + 4 * lq;
        const u32x2 uu = uu8[jd];
        const f32x4 r = (acc + bs) * (f32x4){h_lo(uu.x), h_hi(uu.x), h_lo(uu.y), h_hi(uu.y)};
        u32x2 w; w.x = cvt_pk_h(r[0], r[1]); w.y = cvt_pk_h(r[2], r[3]);
        *(u32x2*)(ZC + (size_t)(t0 + t) * BW + g * 128 + d) = w; }
}

#define XB_TMO      128
#define XB_XCNT(j)  (256  + 64 * (j))
#define XB_XSUB(j)  (1280 + 64 * (j))
#define XB_XGEN(j)  (2304 + 64 * (j))
#define XB_TOP      3328
#define XB_TOPGEN   3392
#define XCD_BAR_WORDS 3456
#define XB_SPIN_CAP (1u << 18)

__device__ __forceinline__ unsigned xb_ld(unsigned* p)              { return __hip_atomic_load(p, __ATOMIC_RELAXED, __HIP_MEMORY_SCOPE_AGENT); }
__device__ __forceinline__ unsigned xb_add(unsigned* p, unsigned v) { return __hip_atomic_fetch_add(p, v, __ATOMIC_RELAXED, __HIP_MEMORY_SCOPE_AGENT); }
__device__ __forceinline__ unsigned xb_xcc_id() { return (unsigned)__builtin_amdgcn_s_getreg((3 << 11) | 20) & 0xFu; }
#define XB_SPIN(cond, bar) do { unsigned _sp = 0; while (cond) { __builtin_amdgcn_s_sleep(1); \
    if ((++_sp & 255u) == 0u) { if (xb_ld(&(bar)[XB_TMO])) break; if (_sp > XB_SPIN_CAP) { atomicAdd(&(bar)[XB_TMO], 1u); break; } } } } while (0)

struct XcdBarrier {
    unsigned* bar; unsigned x;
    volatile LAS unsigned* st;
};

__device__ __forceinline__ XcdBarrier xcd_barrier_post(unsigned* bar, volatile LAS unsigned* st) {
    XcdBarrier b; b.bar = bar; b.x = xb_xcc_id(); b.st = st;
    if (threadIdx.x == 0) (void)xb_add(&bar[XB_XCNT(b.x)], 1u);
    return b;
}
__device__ __forceinline__ void xcd_barrier_complete(unsigned* bar, unsigned x, unsigned& nloc, unsigned& nx) {
    const unsigned G = gridDim.x * gridDim.y * gridDim.z;
    unsigned sum, cnt, mine, sp = 0u;
    for (;;) {
        sum = 0u; cnt = 0u; mine = 0u;
#pragma unroll
        for (unsigned j = 0; j < 16; ++j) { const unsigned c = xb_ld(&bar[XB_XCNT(j)]); sum += c; cnt += (c > 0u) ? 1u : 0u; mine = (j == x) ? c : mine; }
        if (sum == G) break;
        __builtin_amdgcn_s_sleep(1);
        if ((++sp & 255u) == 0u) { if (xb_ld(&bar[XB_TMO])) break; if (sp > XB_SPIN_CAP) { atomicAdd(&bar[XB_TMO], 1u); break; } }
    }
    nloc = mine > 0u ? mine : 1u; nx = cnt > 0u ? cnt : 1u;
}

__device__ __forceinline__ void xcd_barrier(const XcdBarrier& b) {
    asm volatile("s_waitcnt vmcnt(0)" ::: "memory");
    __syncthreads();
    if (threadIdx.x == 0) {
        unsigned* bar = b.bar;
        __builtin_amdgcn_s_waitcnt(0);
        unsigned nloc = b.st[0], nx = b.st[1];
        if (nloc == 0u) { xcd_barrier_complete(bar, b.x, nloc, nx); b.st[0] = nloc; b.st[1] = nx; }
        const unsigned old = xb_add(&bar[XB_XSUB(b.x)], 1u);
        const unsigned gen = old / nloc;
        if (old + 1u == (gen + 1u) * nloc) {
            __builtin_amdgcn_fence(__ATOMIC_RELEASE, "agent");
            asm volatile("s_waitcnt vmcnt(0)" ::: "memory");
            const unsigned og = xb_add(&bar[XB_TOP], 1u);
            const unsigned tg = og / nx;
            if (og + 1u == (tg + 1u) * nx) xb_add(&bar[XB_TOPGEN], 1u);
            else XB_SPIN(xb_ld(&bar[XB_TOPGEN]) == tg, bar);
            __builtin_amdgcn_fence(__ATOMIC_ACQUIRE, "agent");
            xb_add(&bar[XB_XGEN(b.x)], 1u);
            asm volatile("s_waitcnt vmcnt(0)" ::: "memory");
        } else {
            XB_SPIN(xb_ld(&bar[XB_XGEN(b.x)]) == gen, bar);
            __builtin_amdgcn_fence(__ATOMIC_ACQUIRE, "agent");
            asm volatile("s_waitcnt vmcnt(0)" ::: "memory");
        }
    }
    __syncthreads();
}

__global__ void __launch_bounds__(512, 2) mk_fwd(Args a) {
    extern __shared__ __attribute__((aligned(16))) unsigned char lds_raw[];
    LAS unsigned char* lds = (LAS unsigned char*)lds_raw;
    cg::grid_group grid = cg::this_grid();
    if (threadIdx.x < 16) ((LAS unsigned*)(lds + LDS_BARST))[threadIdx.x] = 0u;
    __syncthreads();
    XcdBarrier xbar = xcd_barrier_post((unsigned*)(a.ws + WS_BAR), (volatile LAS unsigned*)(lds + LDS_BARST));
    const int lo = a.ph_lo, hi = a.ph_hi;
    if (lo < 0) grid.sync();
#define IN(k) (lo <= (k) && (k) < hi)
#define SEAM(k) do { if (IN(k) && IN((k) + 1)) xcd_barrier(xbar); } while (0)
#define PHASE_ENV \
    size_t zoff_ = 0; asm volatile("" : "+s"(zoff_)); unsigned char* ws = a.ws + zoff_;     \
    int tid = threadIdx.x; asm volatile("" : "+v"(tid)); \
    int G = gridDim.x, bx = blockIdx.x; asm volatile("" : "+s"(G), "+s"(bx)); \
    const int lane = tid & 63, wave = __builtin_amdgcn_readfirstlane(tid >> 6); \
    const int vcu = (G % 8 == 0) ? (bx % 8) * (G / 8) + bx / 8 : bx; \
    (void)lane; (void)wave; (void)vcu;
    for (int rep_ = 0; rep_ < MK_REP_PRO; ++rep_) { if (IN(0)) { PHASE_ENV; prologue(a, lds, wave, lane, vcu, G); } if (rep_ + 1 < MK_REP_PRO) { asm volatile("s_waitcnt vmcnt(0)" ::: "memory"); __syncthreads(); } }
    SEAM(0);
    for (int l = 0; l < MK_DBG_LAYERS; ++l) {
        const int p0 = 1 + 8 * l;
        for (int rep_ = 0; rep_ < MK_REP_A; ++rep_) {
        if (IN(p0) && MK_DBG_PH > 0) {
            PHASE_ENV;
            pg8::StaticOrder S; S.init(ws + WS_XB, (const bf16_t*)(ws + WS_WIN) + (size_t)l * NIN * D, T, NIN, D, G, bx);
            pg8::EpiA E{(bf16_t*)(ws + WS_P1), (bf16_t*)(ws + WS_G), (const float*)(ws + WS_RSS), (const float*)(ws + WS_LBS) + l * BW};
            pg8::gemm_phase(lds, tid, D, S, E);
        }
        if (IN(p0) && MK_DBG_PH > 0 && l + 1 < DEPTH && rep_ == 0) {
            PHASE_ENV;
            if (G == 256) { if (bx >= 128) convert_layer(a, ws, l + 1, (bx - 128) * 8 + wave, 1024, (LAS float*)(lds + wave * 16640), lane); }
            else convert_layer(a, ws, l + 1, vcu * 8 + wave, G * 8, (LAS float*)(lds + wave * 16640), lane);
        }
        SEAM(p0);
        }
        for (int rep_ = 0; rep_ < MK_REP_B1; ++rep_) {
        if (IN(p0 + 1) && MK_DBG_PH > 1) {
            PHASE_ENV;
            const bf16_t* P1 = (const bf16_t*)(ws + WS_P1);
            if ((1024 % (2 * G)) == 0) { HPre pre[2]; hgrn_load<false>(pre[0], P1, vcu, tid); hgrn_load<false>(pre[1], P1, vcu + G, tid);
              for (int u = vcu; u < 1024; u += 2 * G) hgrn_pass1_pair(P1, pre, u + 2 * G, u + 3 * G, (bf16_t*)(ws + WS_SL), (float*)(ws + WS_DEC), lds, u, u + G, tid, wave, lane); }
            else { HPre pre; hgrn_load<false>(pre, P1, vcu, tid);
              for (int u = vcu; u < 1024; u += G) hgrn_pass1(P1, pre, u + G, (bf16_t*)(ws + WS_SL), (float*)(ws + WS_DEC), lds, u, tid, wave, lane); }
            for (int u = vcu; u < 512; u += G) sg_unit(P1, a.sg_ln_g + l * BW, a.sg_ln_b + l * BW, a.w_sg + (size_t)l * 4 * 128 * 128, a.b_sg + l * 4 * 128, (bf16_t*)(ws + WS_ZC), lds, u, wave, lane);
        }
        SEAM(p0 + 1);
        }
        for (int rep_ = 0; rep_ < MK_REP_B2; ++rep_) {
        if (IN(p0 + 2) && MK_DBG_PH > 2) {
            PHASE_ENV;
            hgrn_scan((const bf16_t*)(ws + WS_SL), (bf16_t*)(ws + WS_ST), (const float*)(ws + WS_DEC), vcu * 512 + tid, G * 512);
        }
        SEAM(p0 + 2);
        }
        for (int rep_ = 0; rep_ < MK_REP_B3; ++rep_) {
        if (IN(p0 + 3) && MK_DBG_PH > 3) {
            PHASE_ENV;
            { const bf16_t* P1 = (const bf16_t*)(ws + WS_P1); HPre pre; hgrn_load<true>(pre, P1, vcu, tid);
              for (int u = vcu; u < 1024; u += G) hgrn_pass3(P1, pre, u + G, (const bf16_t*)(ws + WS_ST), a.g_hgrn_out + l * BW, (bf16_t*)(ws + WS_ZA), lds, u, tid, wave, lane); }
            __syncthreads();
            conv_phase((const bf16_t*)(ws + WS_P1), a.w_conv + (size_t)l * 3 * BW, (bf16_t*)(ws + WS_ZB), vcu * 512 + tid, G * 512);
        }
        SEAM(p0 + 3);
        }
        for (int rep_ = 0; rep_ < MK_REP_C; ++rep_) {
        if (IN(p0 + 4) && MK_DBG_PH > 4) {
            PHASE_ENV;
            pg8::BranchOrder S; S.init(ws + WS_ZA, (size_t)(WS_ZB - WS_ZA), (const bf16_t*)(ws + WS_WBR) + (size_t)l * 3 * D * BW, G, bx);
            pg8::EpiC E{(const bf16_t*)(ws + WS_G), (bf16_t*)(ws + WS_MB)};
            pg8::gemm_phase(lds, tid, BW, S, E);
        }
        SEAM(p0 + 4);
        }
        for (int repd_ = 0; repd_ < MK_REP_D; ++repd_) {
        if (IN(p0 + 5) && MK_DBG_PH > 5) {
            PHASE_ENV;
            pg8::StaticOrder S; S.init(ws + WS_MB, (const bf16_t*)(ws + WS_WO) + (size_t)l * D * D, T, D, D, G, bx);
            pg8::EpiRes E{l == 0 ? a.x : (const float*)a.out, a.out, (bf16_t*)(ws + WS_XB), (float*)(ws + WS_RSS), repd_ + 1 < MK_REP_D};
            pg8::gemm_phase(lds, tid, D, S, E);
        }
        SEAM(p0 + 5);
        }
        for (int rep_ = 0; rep_ < MK_REP_E; ++rep_) {
        if (IN(p0 + 6) && MK_DBG_PH > 6) {
            PHASE_ENV;
            pg8::StaticOrder S; S.init(ws + WS_XB, (const bf16_t*)(ws + WS_W1) + (size_t)l * FF * D, T, FF, D, G, bx);
            pg8::EpiE E{(bf16_t*)(ws + WS_H), (const float*)(ws + WS_RSS)};
            pg8::gemm_phase(lds, tid, D, S, E);
        }
        SEAM(p0 + 6);
        }
        for (int repd_ = 0; repd_ < MK_REP_F; ++repd_) {
        if (IN(p0 + 7) && MK_DBG_PH > 7) {
            PHASE_ENV;
            pg8::StaticOrder S; S.init(ws + WS_H, (const bf16_t*)(ws + WS_W2) + (size_t)l * D * FF, T, D, FF, G, bx);
            pg8::EpiRes E{a.out, a.out, (bf16_t*)(ws + WS_XB), (float*)(ws + WS_RSS), repd_ + 1 < MK_REP_F};
            pg8::gemm_phase(lds, tid, FF, S, E);
        }
        SEAM(p0 + 7);
        }
        for (int rep_ = 0; rep_ < MK_EXTRA_SYNC; ++rep_) SEAM(p0 + 7);
    }
    if (IN(NPH - 1)) {
        PHASE_ENV;
        const float* rss = (const float*)(ws + WS_RSS); float* X = a.out;
        const int gw = vcu * 8 + wave, NGW = G * 8;
        for (int m = gw; m < T; m += NGW) { const float rs = row_rs(rss, m);
            f32x4* xo = (f32x4*)(X + (size_t)m * D) + lane; const f32x4* gf = (const f32x4*)a.g_final + lane;
#pragma unroll
            for (int j = 0; j < 4; ++j) xo[64 * j] = xo[64 * j] * rs * gf[64 * j]; }
    }
#undef IN
#undef SEAM
}

extern "C" void kernel_launch(void* const* d_in, const int* in_sizes, int n_in, void* d_out, int out_size, void* d_ws, size_t ws_size, hipStream_t stream) {
    static int grid = 0;
    if (grid == 0) {
        if (n_in != 16 || in_sizes[0] != T * D || out_size != T * D || ws_size < WS_END) { fprintf(stderr, "kernel_launch: unexpected shapes (n_in %d, in0 %d, out %d, ws %zu < %zu)\n", n_in, n_in > 0 ? in_sizes[0] : -1, out_size, ws_size, (size_t)WS_END); grid = -1; return; }
        int dev = 0, cus = 0, per_cu = 0;
        hipGetDevice(&dev); hipDeviceGetAttribute(&cus, hipDeviceAttributeMultiprocessorCount, dev);
        if (hipFuncSetAttribute((const void*)mk_fwd, hipFuncAttributeMaxDynamicSharedMemorySize, LDS_BYTES) != hipSuccess) { fprintf(stderr, "kernel_launch: hipFuncSetAttribute failed\n"); grid = -1; return; }
        if (hipOccupancyMaxActiveBlocksPerMultiprocessor(&per_cu, (const void*)mk_fwd, 512, LDS_BYTES) != hipSuccess || per_cu < 1) { fprintf(stderr, "kernel_launch: occupancy query says %d\n", per_cu); per_cu = 1; }
        (void)hipGetLastError();
        grid = cus * 1;
    }
    if (grid < 0) return;
    if (hipMemsetAsync((char*)d_ws + WS_BAR, 0, BAR_ZERO_BYTES, stream) != hipSuccess) { fprintf(stderr, "kernel_launch: memset failed\n"); return; }
    Args a{};
    a.x = (const float*)d_in[0]; a.w_in = (const float*)d_in[1]; a.g_mix = (const float*)d_in[2]; a.lower_bounds = (const float*)d_in[3]; a.g_hgrn_out = (const float*)d_in[4];
    a.w_conv = (const float*)d_in[5]; a.sg_ln_g = (const float*)d_in[6]; a.sg_ln_b = (const float*)d_in[7]; a.w_sg = (const float*)d_in[8]; a.b_sg = (const float*)d_in[9];
    a.w_branch = (const float*)d_in[10]; a.w_o = (const float*)d_in[11]; a.g_ffn = (const float*)d_in[12]; a.w_ff1 = (const float*)d_in[13]; a.w_ff2 = (const float*)d_in[14]; a.g_final = (const float*)d_in[15];
    a.out = (float*)d_out; a.ws = (unsigned char*)d_ws;
    a.ph_lo = 0; a.ph_hi = NPH;
    { void* args[] = {&a}; hipError_t e = hipLaunchCooperativeKernel((const void*)mk_fwd, dim3(grid), dim3(512), args, LDS_BYTES, stream);
      if (e != hipSuccess) fprintf(stderr, "cooperative launch failed: %s (grid %d)\n", hipGetErrorString(e), grid); }
}
```

```cpp
#include <hip/hip_runtime.h>
#include <hip/hip_cooperative_groups.h>
#include <cstdio>
#include <cstdint>
namespace cg = cooperative_groups;

#ifndef MK_DBG_LAYERS
#define MK_DBG_LAYERS 4
#endif
#ifndef MK_DBG_PH
#define MK_DBG_PH 8
#endif
#ifndef MK_REP_B1
#define MK_REP_B1 1
#endif
#ifndef MK_REP_B2
#define MK_REP_B2 1
#endif
#ifndef MK_REP_B3
#define MK_REP_B3 1
#endif
#ifndef MK_REP_A
#define MK_REP_A 1
#endif
#ifndef MK_REP_C
#define MK_REP_C 1
#endif
#ifndef MK_REP_E
#define MK_REP_E 1
#endif
#ifndef MK_EXTRA_SYNC
#define MK_EXTRA_SYNC 0
#endif
#ifndef MK_REP_PRO
#define MK_REP_PRO 1
#endif
#ifndef MK_REP_D
#define MK_REP_D 1
#endif
#ifndef MK_REP_F
#define MK_REP_F 1
#endif

#define LAS __attribute__((address_space(3)))
typedef unsigned short bf16_t;
typedef short bf16x8 __attribute__((ext_vector_type(8)));
typedef float f32x4 __attribute__((ext_vector_type(4)));
typedef float f32x2 __attribute__((ext_vector_type(2)));
typedef unsigned u32x4 __attribute__((ext_vector_type(4)));
typedef unsigned u32x2 __attribute__((ext_vector_type(2)));

constexpr int T = 16384, D = 1024, BW = 512, NIN = 7680, FF = 4096, DEPTH = 4, SEQ = 2048;
constexpr int NP1 = 4608, NG = 3072;
constexpr float NORM_EPS = 1e-6f, LN_EPS = 1e-5f;
constexpr size_t MiB = 1u << 20;
constexpr size_t WS_LBS = 64 * 1024, WS_RSS = 128 * 1024, WS_DEC = 1280 * 1024;
constexpr size_t WS_WIN = 2 * MiB, WS_WBR = 62 * MiB, WS_WO = 74 * MiB, WS_W1 = 82 * MiB, WS_W2 = 114 * MiB;
constexpr size_t WS_XB = 146 * MiB, WS_ZA = 146 * MiB, WS_ZB = 162 * MiB, WS_ZC = 178 * MiB;
constexpr size_t WS_P1 = 194 * MiB, WS_H = 194 * MiB, WS_MS = 194 * MiB, WS_G = 338 * MiB, WS_MB = 434 * MiB, WS_ST = 434 * MiB, WS_SL = 146 * MiB, WS_END = 466 * MiB;
constexpr int LDS_BYTES = 147456;
constexpr int LDS_BARST = 147392;
constexpr size_t WS_BAR = 0, BAR_ZERO_BYTES = 16384;
constexpr int NPH = 2 + 8 * DEPTH;

typedef __bf16 bf16v2_t __attribute__((ext_vector_type(2)));
typedef _Float16 h16v2_t __attribute__((ext_vector_type(2)));
typedef _Float16 h16x8 __attribute__((ext_vector_type(8)));
__device__ __forceinline__ unsigned cvt_pk_truebf16(float lo, float hi) { bf16v2_t v; v.x = (__bf16)lo; v.y = (__bf16)hi; return __builtin_bit_cast(unsigned, v); }
__device__ __forceinline__ unsigned cvt_pk_h(float lo, float hi) { h16v2_t v; v.x = (_Float16)lo; v.y = (_Float16)hi; return __builtin_bit_cast(unsigned, v); }
__device__ __forceinline__ float h_lo(unsigned w) { return (float)__builtin_bit_cast(h16v2_t, w).x; }
__device__ __forceinline__ float h_hi(unsigned w) { return (float)__builtin_bit_cast(h16v2_t, w).y; }
#define MFMA_H(a, b, c) __builtin_amdgcn_mfma_f32_16x16x32_f16(__builtin_bit_cast(h16x8, (a)), __builtin_bit_cast(h16x8, (b)), (c), 0, 0, 0)
__device__ __forceinline__ float fast_sigmoid(float x) { return __builtin_amdgcn_rcpf(1.0f + __expf(-x)); }
#define DPP_ADD(v, ctrl) ((v) + __builtin_bit_cast(float, __builtin_amdgcn_update_dpp(0, __builtin_bit_cast(int, (v)), (ctrl), 0xf, 0xf, true)))
__device__ __forceinline__ float wave_sum(float v) {
    v = DPP_ADD(v, 0xB1); v = DPP_ADD(v, 0x4E); v = DPP_ADD(v, 0x124); v = DPP_ADD(v, 0x128);
    const int iv = __builtin_bit_cast(int, v);
    const float r0 = __builtin_bit_cast(float, __builtin_amdgcn_readlane(iv, 0)), r1 = __builtin_bit_cast(float, __builtin_amdgcn_readlane(iv, 16)), r2 = __builtin_bit_cast(float, __builtin_amdgcn_readlane(iv, 32)), r3 = __builtin_bit_cast(float, __builtin_amdgcn_readlane(iv, 48));
    return (r0 + r1) + (r2 + r3);
}
__device__ __forceinline__ float row_rs(const float* rss, int row) {
    const f32x4* p = (const f32x4*)(rss + (size_t)row * 16);
    const f32x4 a = p[0], b = p[1], c = p[2], d = p[3];
    const float s = ((a.x + a.y) + (a.z + a.w)) + ((b.x + b.y) + (b.z + b.w)) + ((c.x + c.y) + (c.z + c.w)) + ((d.x + d.y) + (d.z + d.w));
    return rsqrtf(s * (1.0f / D) + NORM_EPS);
}
__device__ __forceinline__ float row_rs4(const float* rss, int row, int fq) {
    const f32x4 a = *(const f32x4*)(rss + (size_t)row * 16 + 4 * fq);
    float s = (a.x + a.y) + (a.z + a.w);
    s += __shfl_xor(s, 16); s += __shfl_xor(s, 32);
    return rsqrtf(s * (1.0f / D) + NORM_EPS);
}

namespace pg8 {
constexpr int BM = 256, BK = 64, HALF = 128, HTB = HALF * BK * 2, STAGE_BYTES = 8 * HTB, NXCD = 8, WGM = 8;
__host__ __device__ __forceinline__ int lds_byte(int r, int c) { const int st = (r >> 4) * 2 + (c >> 5), rr = r & 15, cc = c & 31, ob = rr * 64 + cc * 2; return st * 1024 + (ob ^ (((ob >> 9) & 1) << 5)); }
__host__ __device__ __forceinline__ void stage_rc(int b, int& R, int& C) { const int st = b / 1024, sb = b % 1024, swz = sb ^ (((sb >> 9) & 1) << 5); R = (st >> 1) * 16 + swz / 64; C = (st & 1) * 32 + (swz % 64) / 2; }
__host__ __device__ __forceinline__ int perm32(int rho) { const int n = rho >> 4, i = rho & 15; return 8 * (i >> 2) + 4 * n + (i & 3); }

struct Unit { int pm, pn, br; };
__device__ __forceinline__ void tile_map(int wgid, int nM, int nN, int& pm, int& pn) {
    const int nwg = nM * nN;
    { const int q = nwg / NXCD, r = nwg % NXCD, xcd = wgid % NXCD, off = wgid / NXCD; wgid = (xcd < r ? xcd * (q + 1) : r * (q + 1) + (xcd - r) * q) + off; }
    const int nig = WGM * nN, gid = wgid / nig, fm = gid * WGM, gsz = (nM - fm) < WGM ? (nM - fm) : WGM;
    pm = fm + ((wgid % nig) % gsz); pn = (wgid % nig) / gsz;
}
struct StaticOrder {
    int nM, nN, nwg, G, c; const char* A; const char* Bt; size_t tstep;
    __device__ void init(const void* A_, const void* Bt_, int M, int N, int K, int G_, int c_) { nM = M / BM; nN = N / BM; nwg = nM * nN; G = G_; c = c_; A = (const char*)A_; Bt = (const char*)Bt_; tstep = (size_t)BM * K * 2; }
    __device__ __forceinline__ bool next(int i, Unit& u) const { const long L = (long)i * G + c; if (L >= nwg) return false; tile_map((int)L, nM, nN, u.pm, u.pn); u.br = 0; return true; }
    __device__ __forceinline__ const char* a_ptr(const Unit& u) const { return A + (size_t)u.pm * tstep; }
    __device__ __forceinline__ const char* b_ptr(const Unit& u) const { return Bt + (size_t)u.pn * tstep; }
};
struct BranchOrder {
    int nM, nN, nwg, G, c; const char* Z; const char* Wb; size_t tstep, zstride, wstride;
    __device__ void init(const void* Z_, size_t zstride_, const void* Wb_, int G_, int c_) { nM = T / BM; nN = D / BM; nwg = nM * nN; G = G_; c = c_; Z = (const char*)Z_; Wb = (const char*)Wb_; tstep = (size_t)BM * BW * 2; zstride = zstride_; wstride = (size_t)D * BW * 2; }
    __device__ __forceinline__ bool next(int i, Unit& u) const { const int r = i / 3; const long L = (long)r * G + c; if (L >= nwg) return false; tile_map((int)L, nM, nN, u.pm, u.pn); u.br = i - 3 * r; return true; }
    __device__ __forceinline__ const char* a_ptr(const Unit& u) const { return Z + (size_t)u.br * zstride + (size_t)u.pm * tstep; }
    __device__ __forceinline__ const char* b_ptr(const Unit& u) const { return Wb + (size_t)u.br * wstride + (size_t)u.pn * tstep; }
};

template <class Epi, class Sched>
__device__ __forceinline__ void gemm_phase(LAS unsigned char* lds, const int tid, const int K, const Sched& S, const Epi& E) {
    const int wid = __builtin_amdgcn_readfirstlane(tid >> 6), lane = tid & 63, wr = wid >> 2, wc = wid & 3, fr = lane & 15, fq = lane >> 4;
    const int nt = K / BK;
    unsigned voffA[2], voffB[2];
#pragma unroll
    for (int i = 0; i < 2; ++i) { int R, C; stage_rc(tid * 16 + i * 8192, R, C); const int Rb = (R & ~31) + perm32(R & 31);
        voffA[i] = (unsigned)(R * K + C) * 2u; voffB[i] = (unsigned)(Rb * K + C) * 2u; }
    const size_t kstep = (size_t)(BK * 2);
    const size_t hstep = (size_t)HALF * K * 2;
    const unsigned ldsw = (unsigned)wid * 1024u;
    const int aoff = lds_byte(wr * 64 + fr, fq * 8), boff = lds_byte(wc * 32 + fr, fq * 8);
#define PG8_SA(b, h) (((b) * 2 + (h)) * HTB)
#define PG8_SB(b, h) ((4 + (b) * 2 + (h)) * HTB)
#define PG8_STAGE(bufoff, gbase, voff) do { _Pragma("unroll") for (int _i = 0; _i < 2; ++_i) \
        __builtin_amdgcn_global_load_lds((const unsigned*)((const char*)(gbase) + (voff)[_i]), (LAS unsigned*)(lds + (bufoff) + ldsw + _i * 8192), 16, 0, 0); } while (0)
#define PG8_LDA(dst, b, h) do { _Pragma("unroll") for (int m = 0; m < 4; ++m) _Pragma("unroll") for (int k = 0; k < 2; ++k) dst[m][k] = *(const LAS bf16x8*)(lds + PG8_SA(b, h) + aoff + m * 2048 + k * 1024); } while (0)
#define PG8_LDB(dst, b, h) do { _Pragma("unroll") for (int n = 0; n < 2; ++n) _Pragma("unroll") for (int k = 0; k < 2; ++k) dst[n][k] = *(const LAS bf16x8*)(lds + PG8_SB(b, h) + boff + n * 2048 + k * 1024); } while (0)
#define PG8_MMA(ai, bj, At, Bt) do { __builtin_amdgcn_s_setprio(1); _Pragma("unroll") for (int m = 0; m < 4; ++m) _Pragma("unroll") for (int n = 0; n < 2; ++n) _Pragma("unroll") for (int k = 0; k < 2; ++k) \
        acc[ai][bj][m][n] = MFMA_H(Bt[n][k], At[m][k], acc[ai][bj][m][n]); __builtin_amdgcn_s_setprio(0); } while (0)
#define PG8_WAIT_V(n) asm volatile("s_waitcnt vmcnt(" #n ")" ::: "memory")
#define PG8_WAIT_L(n) asm volatile("s_waitcnt lgkmcnt(" #n ")" ::: "memory")
#define PG8_BAR __builtin_amdgcn_s_barrier()
#define PG8_SCHED __builtin_amdgcn_sched_barrier(0)
    Unit cur, nxt; int ui = 0;
    if (!S.next(0, cur)) return;
    f32x4 acc[2][2][4][2];
#pragma unroll
    for (int a = 0; a < 2; ++a)
#pragma unroll
        for (int b = 0; b < 2; ++b)
#pragma unroll
            for (int m = 0; m < 4; ++m)
#pragma unroll
                for (int n = 0; n < 2; ++n) acc[a][b][m][n] = (f32x4){0.f, 0.f, 0.f, 0.f};
    bf16x8 At[4][2], B0[2][2], B1[2][2];
    const char* cA = S.a_ptr(cur); const char* cB = S.b_ptr(cur);
    PG8_STAGE(PG8_SB(0, 0), cB, voffB); PG8_STAGE(PG8_SB(0, 1), cB + hstep, voffB); PG8_STAGE(PG8_SA(0, 0), cA, voffA); PG8_STAGE(PG8_SA(0, 1), cA + hstep, voffA);
    if (wr == 1) PG8_BAR;
    PG8_WAIT_V(2); PG8_BAR;
    PG8_STAGE(PG8_SB(1, 0), cB + kstep, voffB); PG8_STAGE(PG8_SA(1, 0), cA + kstep, voffA); PG8_STAGE(PG8_SB(1, 1), cB + hstep + kstep, voffB);
    PG8_WAIT_V(6); PG8_BAR;
    for (;;) {
        const bool has_next = S.next(ui + 1, nxt);
        const char* nA = has_next ? S.a_ptr(nxt) : cA; const char* nB = has_next ? S.b_ptr(nxt) : cB;
        for (int t = 0; t < nt; t += 2) {
            const bool last = (t == nt - 2);
            const char* a1 = cA + (size_t)(t + 1) * kstep;
            const char* a2 = last ? nA : cA + (size_t)(t + 2) * kstep; const char* b2 = last ? nB : cB + (size_t)(t + 2) * kstep;
            const char* a3 = a2 + kstep; const char* b3 = b2 + kstep;
            PG8_LDB(B0, 0, 0); PG8_LDB(B1, 0, 1); PG8_SCHED; PG8_LDA(At, 0, 0); PG8_STAGE(PG8_SA(1, 1), a1 + hstep, voffA);
            PG8_WAIT_V(8); PG8_WAIT_L(0); PG8_BAR; PG8_MMA(0, 0, At, B0); PG8_MMA(0, 1, At, B1); PG8_BAR; PG8_SCHED;
            PG8_LDA(At, 0, 1); PG8_STAGE(PG8_SB(0, 0), b2, voffB); PG8_STAGE(PG8_SB(0, 1), b2 + hstep, voffB); PG8_STAGE(PG8_SA(0, 0), a2, voffA);
            PG8_WAIT_V(8); PG8_WAIT_L(0); PG8_BAR; PG8_MMA(1, 0, At, B0); PG8_MMA(1, 1, At, B1); PG8_BAR; PG8_SCHED;
            PG8_LDB(B0, 1, 0); PG8_LDB(B1, 1, 1); PG8_SCHED; PG8_LDA(At, 1, 0); PG8_STAGE(PG8_SA(0, 1), a2 + hstep, voffA);
            PG8_WAIT_V(8); PG8_WAIT_L(0); PG8_BAR; PG8_MMA(0, 0, At, B0); PG8_MMA(0, 1, At, B1); PG8_BAR; PG8_SCHED;
            PG8_LDA(At, 1, 1); PG8_STAGE(PG8_SB(1, 0), b3, voffB); PG8_STAGE(PG8_SB(1, 1), b3 + hstep, voffB); PG8_STAGE(PG8_SA(1, 0), a3, voffA);
            PG8_WAIT_V(8); PG8_WAIT_L(0); PG8_BAR; PG8_MMA(1, 0, At, B0); PG8_MMA(1, 1, At, B1); PG8_BAR; PG8_SCHED;
        }
        if (wr == 0) PG8_BAR;
        E(acc, cur, wr, wc, fr, fq);
        if (!has_next) break;
        if (!(Epi::KEEPS && E.keep(cur))) {
#pragma unroll
        for (int a = 0; a < 2; ++a)
#pragma unroll
            for (int b = 0; b < 2; ++b)
#pragma unroll
                for (int m = 0; m < 4; ++m)
#pragma unroll
                    for (int n = 0; n < 2; ++n) acc[a][b][m][n] = (f32x4){0.f, 0.f, 0.f, 0.f};
        }
        cur = nxt; cA = nA; cB = nB; ++ui;
        if (wr == 1) PG8_BAR;
    }
    PG8_WAIT_V(0);
    PG8_BAR;
#undef PG8_SA
#undef PG8_SB
#undef PG8_STAGE
#undef PG8_LDA
#undef PG8_LDB
#undef PG8_MMA
#undef PG8_WAIT_V
#undef PG8_WAIT_L
#undef PG8_BAR
#undef PG8_SCHED
}

struct EpiA {
    static constexpr bool KEEPS = false;
    __device__ __forceinline__ bool keep(const Unit&) const { return false; }
    bf16_t* P1; bf16_t* G; const float* rss; const float* lbs_l;
    __device__ __forceinline__ void operator()(f32x4 (&acc)[2][2][4][2], const Unit& u, int wr, int wc, int fr, int fq) const {
        const int fn = u.pn >> 1;
        const int act = (fn == 0) ? 1 : ((fn == 3 || fn >= 9) ? 2 : ((fn == 7 || fn == 8) ? 3 : ((fn == 1) ? 4 : 0)));
        bf16_t* base; int ldc, colt;
        if (u.pn < 18) { base = P1; ldc = NP1; colt = u.pn * BM; } else { base = G; ldc = NG; colt = u.pn * BM - NP1; }
        const int row0 = u.pm * BM + wr * 64 + fr, col0 = colt + wc * 32 + 8 * fq;
        float lbv[2][8];
#pragma unroll
        for (int bj = 0; bj < 2; ++bj)
#pragma unroll
            for (int j = 0; j < 8; ++j) lbv[bj][j] = 0.f;
        if (act == 4) {
#pragma unroll
            for (int bj = 0; bj < 2; ++bj) { const f32x4 a = *(const f32x4*)(lbs_l + col0 - BW + bj * HALF), b = *(const f32x4*)(lbs_l + col0 - BW + bj * HALF + 4);
                lbv[bj][0] = a.x; lbv[bj][1] = a.y; lbv[bj][2] = a.z; lbv[bj][3] = a.w; lbv[bj][4] = b.x; lbv[bj][5] = b.y; lbv[bj][6] = b.z; lbv[bj][7] = b.w; } }
#pragma unroll
        for (int ai = 0; ai < 2; ++ai)
#pragma unroll
            for (int m = 0; m < 4; ++m) { const int row = row0 + ai * HALF + m * 16; const float rs = row_rs4(rss, row, fq);
                bf16_t* rowp = base + (size_t)row * ldc + col0;
#pragma unroll
                for (int bj = 0; bj < 2; ++bj) { float v[8];
#pragma unroll
                    for (int j = 0; j < 4; ++j) { v[j] = acc[ai][bj][m][0][j] * rs; v[4 + j] = acc[ai][bj][m][1][j] * rs; }
                    if (act == 2) {
#pragma unroll
                        for (int j = 0; j < 8; ++j) v[j] = __builtin_amdgcn_rcpf(1.0f + __builtin_amdgcn_exp2f(v[j] * -1.4426950409f));
                    } else if (act == 1) {
#pragma unroll
                        for (int j = 0; j < 8; ++j) v[j] = v[j] * __builtin_amdgcn_rcpf(1.0f + __builtin_amdgcn_exp2f(v[j] * -1.4426950409f));
                    } else if (act == 3) {
#pragma unroll
                        for (int j = 0; j < 8; ++j) { const float x = v[j], y = x * (-2.3022082f + -0.1029432f * x * x); v[j] = x * __builtin_amdgcn_rcpf(1.0f + __builtin_amdgcn_exp2f(y)); }
                    } else if (act == 4) {
#pragma unroll
                        for (int j = 0; j < 8; ++j) { const float x = fminf(fmaxf(v[j], -30.f), 30.f), s = __builtin_amdgcn_rcpf(1.0f + __builtin_amdgcn_exp2f(x * -1.4426950409f)); v[j] = lbv[bj][j] + (1.0f - lbv[bj][j]) * s; }
                    }
                    u32x4 w; w.x = cvt_pk_h(v[0], v[1]); w.y = cvt_pk_h(v[2], v[3]); w.z = cvt_pk_h(v[4], v[5]); w.w = cvt_pk_h(v[6], v[7]);
                    *(u32x4*)(rowp + bj * HALF) = w; } }
    }
};
struct EpiC {
    const bf16_t* G; bf16_t* MB;
    static constexpr bool KEEPS = true;
    __device__ __forceinline__ bool keep(const Unit& u) const { return u.br != 2; }
    __device__ __forceinline__ void operator()(f32x4 (&acc)[2][2][4][2], const Unit& u, int wr, int wc, int fr, int fq) const {
        const int row0 = u.pm * BM + wr * 64 + fr, col0 = u.pn * BM + wc * 32 + 8 * fq; const int br = u.br;
#pragma unroll
        for (int ai = 0; ai < 2; ++ai)
#pragma unroll
            for (int m = 0; m < 4; ++m) { const int row = row0 + ai * HALF + m * 16;
#pragma unroll
                for (int bj = 0; bj < 2; ++bj) { const int col = col0 + bj * HALF;
                    const u32x4 g = *(const u32x4*)(G + (size_t)row * NG + br * D + col);
                    f32x4 s0 = (f32x4){h_lo(g.x), h_hi(g.x), h_lo(g.y), h_hi(g.y)}, s1 = (f32x4){h_lo(g.z), h_hi(g.z), h_lo(g.w), h_hi(g.w)};
#pragma unroll
                    for (int j = 0; j < 4; ++j) { s0[j] = fmaxf(s0[j], 5.9604645e-8f); s1[j] = fmaxf(s1[j], 5.9604645e-8f); }
                    if (br != 2) { const u32x4 gn = *(const u32x4*)(G + (size_t)row * NG + (br + 1) * D + col);
                        const f32x4 d0 = (f32x4){h_lo(gn.x), h_hi(gn.x), h_lo(gn.y), h_hi(gn.y)}, d1 = (f32x4){h_lo(gn.z), h_hi(gn.z), h_lo(gn.w), h_hi(gn.w)};
#pragma unroll
                        for (int j = 0; j < 4; ++j) { s0[j] *= __builtin_amdgcn_rcpf(fmaxf(d0[j], 5.9604645e-8f)); s1[j] *= __builtin_amdgcn_rcpf(fmaxf(d1[j], 5.9604645e-8f)); }
                        acc[ai][bj][m][0] *= s0; acc[ai][bj][m][1] *= s1;
                    } else { const f32x4 v0 = acc[ai][bj][m][0] * s0, v1 = acc[ai][bj][m][1] * s1;
                        u32x4 w; w.x = cvt_pk_h(v0[0], v0[1]); w.y = cvt_pk_h(v0[2], v0[3]); w.z = cvt_pk_h(v1[0], v1[1]); w.w = cvt_pk_h(v1[2], v1[3]);
                        *(u32x4*)(MB + (size_t)row * D + col) = w; } } }
    }
};
struct EpiRes {
    static constexpr bool KEEPS = false;
    __device__ __forceinline__ bool keep(const Unit&) const { return false; }
    const float* Xin; float* X; bf16_t* XB; float* rss; int dummy;
    __device__ __forceinline__ void operator()(f32x4 (&acc)[2][2][4][2], const Unit& u, int wr, int wc, int fr, int fq) const {
        const int row0 = u.pm * BM + wr * 64 + fr, col0 = u.pn * BM + wc * 32 + 8 * fq;
#pragma unroll
        for (int ai = 0; ai < 2; ++ai)
#pragma unroll
            for (int m = 0; m < 4; ++m) { const int row = row0 + ai * HALF + m * 16; float ss = 0.f;
#pragma unroll
                for (int bj = 0; bj < 2; ++bj) { const int col = col0 + bj * HALF; float* xp = X + (size_t)row * D + col; const float* xi = Xin + (size_t)row * D + col;
                    const f32x4 x0 = *(const f32x4*)xi + acc[ai][bj][m][0], x1 = *(const f32x4*)(xi + 4) + acc[ai][bj][m][1];
                    if (!dummy) { *(f32x4*)xp = x0; *(f32x4*)(xp + 4) = x1; }
                    ss += (x0[0] * x0[0] + x0[1] * x0[1]) + (x0[2] * x0[2] + x0[3] * x0[3]) + (x1[0] * x1[0] + x1[1] * x1[1]) + (x1[2] * x1[2] + x1[3] * x1[3]);
                    u32x4 w; w.x = cvt_pk_h(x0[0], x0[1]); w.y = cvt_pk_h(x0[2], x0[3]); w.z = cvt_pk_h(x1[0], x1[1]); w.w = cvt_pk_h(x1[2], x1[3]);
                    if (!dummy || ss == 12345.678f) *(u32x4*)(XB + (size_t)row * D + col) = w; }
                ss += __shfl_xor(ss, 16); ss += __shfl_xor(ss, 32);
                if (fq == 0 && (!dummy || ss == 12345.678f)) rss[(size_t)row * 16 + u.pn * 4 + wc] = ss; }
    }
};
struct EpiE {
    static constexpr bool KEEPS = false;
    __device__ __forceinline__ bool keep(const Unit&) const { return false; }
    bf16_t* H; const float* rss;
    __device__ __forceinline__ void operator()(f32x4 (&acc)[2][2][4][2], const Unit& u, int wr, int wc, int fr, int fq) const {
        const int row0 = u.pm * BM + wr * 64 + fr, col0 = u.pn * BM + wc * 32 + 8 * fq;
#pragma unroll
        for (int ai = 0; ai < 2; ++ai)
#pragma unroll
            for (int m = 0; m < 4; ++m) { const int row = row0 + ai * HALF + m * 16; const float rs = row_rs4(rss, row, fq);
#pragma unroll
                for (int bj = 0; bj < 2; ++bj) { float v[8];
#pragma unroll
                    for (int j = 0; j < 4; ++j) { const float a = fmaxf(acc[ai][bj][m][0][j] * rs, 0.f), b = fmaxf(acc[ai][bj][m][1][j] * rs, 0.f); v[j] = a * a; v[4 + j] = b * b; }
                    u32x4 w; w.x = cvt_pk_h(v[0], v[1]); w.y = cvt_pk_h(v[2], v[3]); w.z = cvt_pk_h(v[4], v[5]); w.w = cvt_pk_h(v[6], v[7]);
                    *(u32x4*)(H + (size_t)row * FF + col0 + bj * HALF) = w; } }
    }
};
}

struct TDesc { const float* W; const float* gs; bf16_t* WT; int K, N, item; };
__device__ __forceinline__ void titem_load(const TDesc& d, f32x4 (&v)[16], int lane) {
    const int nblk = d.N / 64, kb = d.item / nblk, nb = d.item - kb * nblk, k0 = 64 * kb, n0 = 64 * nb;
    const int lr = lane >> 4, lc = (lane & 15) * 4;
#pragma unroll
    for (int i = 0; i < 16; ++i) v[i] = *(const f32x4*)(d.W + (size_t)(k0 + 4 * i + lr) * d.N + n0 + lc);
}
__device__ __forceinline__ void titem_finish(const TDesc& d, const f32x4 (&v)[16], LAS float* scr, int lane) {
    const int nblk = d.N / 64, kb = d.item / nblk, nb = d.item - kb * nblk, k0 = 64 * kb, n0 = 64 * nb;
    const int lr = lane >> 4, lc = (lane & 15) * 4;
#pragma unroll
    for (int i = 0; i < 16; ++i) { LAS float* p = scr + (4 * i + lr) * 65 + lc; p[0] = v[i].x; p[1] = v[i].y; p[2] = v[i].z; p[3] = v[i].w; }
    asm volatile("s_waitcnt lgkmcnt(0)" ::: "memory");
    const int c = lane & 7;
    f32x4 g0 = (f32x4){1.f, 1.f, 1.f, 1.f}, g1 = g0;
    if (d.gs) { g0 = *(const f32x4*)(d.gs + k0 + 8 * c); g1 = *(const f32x4*)(d.gs + k0 + 8 * c + 4); }
#pragma unroll
    for (int j = 0; j < 8; ++j) { const int n = (lane >> 3) + 8 * j; const LAS float* s = scr + (8 * c) * 65 + n;
        u32x4 o; o.x = cvt_pk_h(s[0 * 65] * g0.x, s[1 * 65] * g0.y); o.y = cvt_pk_h(s[2 * 65] * g0.z, s[3 * 65] * g0.w); o.z = cvt_pk_h(s[4 * 65] * g1.x, s[5 * 65] * g1.y); o.w = cvt_pk_h(s[6 * 65] * g1.z, s[7 * 65] * g1.w);
        *(u32x4*)(d.WT + (size_t)(n0 + n) * d.K + k0 + 8 * c) = o; }
    asm volatile("s_waitcnt lgkmcnt(0)" ::: "memory");
}
struct Args {
    const float* x; const float* w_in; const float* g_mix; const float* lower_bounds; const float* g_hgrn_out; const float* w_conv;
    const float* sg_ln_g; const float* sg_ln_b; const float* w_sg; const float* b_sg; const float* w_branch; const float* w_o;
    const float* g_ffn; const float* w_ff1; const float* w_ff2; const float* g_final;
    float* out; unsigned char* ws; int ph_lo, ph_hi;
};

__device__ __forceinline__ TDesc layer_item(const Args& a, unsigned char* ws, int l, int r) {
    constexpr int I_IN = (D / 64) * (NIN / 64), I_BR = (BW / 64) * (D / 64), I_O = (D / 64) * (D / 64), I_1 = (D / 64) * (FF / 64);
    TDesc d;
    if (r < I_IN) { d.W = a.w_in + (size_t)l * D * NIN; d.gs = a.g_mix + l * D; d.WT = (bf16_t*)(ws + WS_WIN) + (size_t)l * NIN * D; d.K = D; d.N = NIN; d.item = r; return d; } r -= I_IN;
    if (r < 3 * I_BR) { const int br = r / I_BR; d.W = a.w_branch + (size_t)(l * 3 + br) * BW * D; d.gs = nullptr; d.WT = (bf16_t*)(ws + WS_WBR) + (size_t)(l * 3 + br) * D * BW; d.K = BW; d.N = D; d.item = r - br * I_BR; return d; } r -= 3 * I_BR;
    if (r < I_O) { d.W = a.w_o + (size_t)l * D * D; d.gs = nullptr; d.WT = (bf16_t*)(ws + WS_WO) + (size_t)l * D * D; d.K = D; d.N = D; d.item = r; return d; } r -= I_O;
    if (r < I_1) { d.W = a.w_ff1 + (size_t)l * D * FF; d.gs = a.g_ffn + l * D; d.WT = (bf16_t*)(ws + WS_W1) + (size_t)l * FF * D; d.K = D; d.N = FF; d.item = r; return d; } r -= I_1;
    d.W = a.w_ff2 + (size_t)l * FF * D; d.gs = nullptr; d.WT = (bf16_t*)(ws + WS_W2) + (size_t)l * D * FF; d.K = FF; d.N = D; d.item = r; return d;
}
__device__ __forceinline__ void convert_layer(const Args& a, unsigned char* ws, int l, int worker, int nworkers, LAS float* scr, int lane) {
    constexpr int NITEMS = (D / 64) * (NIN / 64) + 3 * (BW / 64) * (D / 64) + (D / 64) * (D / 64) + (D / 64) * (FF / 64) + (FF / 64) * (D / 64);
    int it = worker; if (it >= NITEMS) return;
    TDesc dc = layer_item(a, ws, l, it); f32x4 vc[16]; titem_load(dc, vc, lane);
    for (;;) { const int nx = it + nworkers; const bool has = nx < NITEMS;
        TDesc dn = dc; f32x4 vn[16];
#pragma unroll
        for (int i = 0; i < 16; ++i) vn[i] = vc[i];
        if (has) { dn = layer_item(a, ws, l, nx); titem_load(dn, vn, lane); }
        titem_finish(dc, vc, scr, lane);
        if (!has) break;
        dc = dn; it = nx;
#pragma unroll
        for (int i = 0; i < 16; ++i) vc[i] = vn[i]; }
}

__device__ __forceinline__ void prologue(const Args& a, LAS unsigned char* lds, int wave, int lane, int vcu, int G) {
    unsigned char* ws = a.ws;
    LAS float* scr = (LAS float*)(lds + wave * 16640);
    const int gw = vcu * 8 + wave, NGW = G * 8;
    convert_layer(a, ws, 0, gw, NGW, scr, lane);
    bf16_t* XB = (bf16_t*)(ws + WS_XB); float* rss = (float*)(ws + WS_RSS);
    for (int m = gw; m < T; m += NGW) {
        const f32x4* xr = (const f32x4*)(a.x + (size_t)m * D) + lane; u32x2* bo = (u32x2*)(XB + (size_t)m * D) + lane;
        float s = 0.f;
#pragma unroll
        for (int j = 0; j < 4; ++j) { const f32x4 v = xr[64 * j]; s += (v.x * v.x + v.y * v.y) + (v.z * v.z + v.w * v.w);
            u32x2 w; w.x = cvt_pk_h(v.x, v.y); w.y = cvt_pk_h(v.z, v.w); bo[64 * j] = w; }
        s = wave_sum(s);
        if (lane < 16) rss[(size_t)m * 16 + lane] = (lane == 0) ? s : 0.f;
    }
    if (vcu == 0) { const int w = wave * 64 + lane; float* lbs = (float*)(ws + WS_LBS);
        float v[DEPTH]; float mx = -1e30f;
#pragma unroll
        for (int i = 0; i < DEPTH; ++i) { v[i] = a.lower_bounds[i * BW + w]; mx = fmaxf(mx, v[i]); }
        float sum = 0.f;
#pragma unroll
        for (int i = 0; i < DEPTH; ++i) { v[i] = __expf(v[i] - mx); sum += v[i]; }
        float cum = 0.f; const float inv = 1.0f / sum;
#pragma unroll
        for (int i = 0; i < DEPTH; ++i) { if (i > 0) cum += v[i] * inv; lbs[i * BW + w] = cum; }
    }
}

__device__ __forceinline__ void unpack8(const u32x4 w, float (&f)[8]) { f[0] = h_lo(w.x); f[1] = h_hi(w.x); f[2] = h_lo(w.y); f[3] = h_hi(w.y); f[4] = h_lo(w.z); f[5] = h_hi(w.z); f[6] = h_lo(w.w); f[7] = h_hi(w.w); }
__device__ __forceinline__ u32x4 pack8(const float (&f)[8]) { u32x4 w; w.x = cvt_pk_h(f[0], f[1]); w.y = cvt_pk_h(f[2], f[3]); w.z = cvt_pk_h(f[4], f[5]); w.w = cvt_pk_h(f[6], f[7]); return w; }
__device__ __forceinline__ u32x4 pack8_truebf16(const float (&f)[8]) { u32x4 w; w.x = cvt_pk_truebf16(f[0], f[1]); w.y = cvt_pk_truebf16(f[2], f[3]); w.z = cvt_pk_truebf16(f[4], f[5]); w.w = cvt_pk_truebf16(f[6], f[7]); return w; }
__device__ __forceinline__ unsigned short bf16_of(float f) { return (unsigned short)(cvt_pk_h(f, 0.f) & 0xffffu); }

constexpr int HL_BL = 0;
constexpr int HL_SEG = 32768;
constexpr int HL_A1 = 34816;
constexpr int HL_BK = HL_A1 + 17408;
constexpr int HL_QH = HL_BK + 17408;
constexpr int HL_VT = HL_QH + 17408;
constexpr int HL_P = HL_VT + 18432;
constexpr int HL_RS = HL_P + 9216;
constexpr int HL_KT = HL_A1;
static_assert(HL_RS + 512 <= LDS_BYTES, "hgrn lds");

struct HPre { u32x4 f[2], iv[2]; };
template <bool WANT_Q> __device__ __forceinline__ void hgrn_load(HPre& p, const bf16_t* P1, int unit, int tid) {
    const int bh = unit >> 5, c = unit & 31, t0 = (bh >> 2) * SEQ + c * 64, ch0 = (bh & 3) * 128, c8 = tid & 15;
#pragma unroll
    for (int j = 0; j < 2; ++j) { const bf16_t* rp = P1 + (size_t)(t0 + (tid >> 4) + 32 * j) * NP1 + ch0 + 8 * c8;
        p.f[j] = *(const u32x4*)(rp + BW); p.iv[j] = *(const u32x4*)(rp + 2 * BW); }
}
__device__ __forceinline__ void hgrn_prep(const HPre& pre, LAS unsigned char* lds, int tid, float (&kk)[2][8]) {
    LAS float* BL = (LAS float*)(lds + HL_BL); LAS float* SEG = (LAS float*)(lds + HL_SEG);
    const int c8 = tid & 15;
#pragma unroll
    for (int j = 0; j < 2; ++j) { const int r = (tid >> 4) + 32 * j;
        float f[8]; unpack8(pre.f[j], f);
        float lf[8];
#pragma unroll
        for (int e = 0; e < 8; ++e) { lf[e] = __logf(fmaxf(f[e], 5.9604645e-8f)); kk[j][e] = 1.0f - f[e]; }
        *(LAS f32x4*)(BL + r * 128 + 8 * c8) = (f32x4){lf[0], lf[1], lf[2], lf[3]}; *(LAS f32x4*)(BL + r * 128 + 8 * c8 + 4) = (f32x4){lf[4], lf[5], lf[6], lf[7]}; }
    __syncthreads();
    { const int ch = tid & 127, seg = tid >> 7; float v[16]; float run = 0.f;
#pragma unroll
      for (int j = 0; j < 16; ++j) { run += BL[(seg * 16 + j) * 128 + ch]; v[j] = run; }
      SEG[seg * 128 + ch] = run;
      __syncthreads();
      float pre = 0.f;
#pragma unroll
      for (int s = 0; s < 3; ++s) { const float tot = SEG[s * 128 + ch]; if (s < seg) pre += tot; }
#pragma unroll
      for (int j = 0; j < 16; ++j) BL[(seg * 16 + j) * 128 + ch] = v[j] + pre; }
    __syncthreads();
}

__device__ __forceinline__ void hgrn_pass1(const bf16_t* P1, HPre& pre, int next_unit, bf16_t* ST, float* DEC, LAS unsigned char* lds, int unit, int tid, int wave, int lane) {
    const int bh = unit >> 5, c = unit & 31, b = bh >> 2, h = bh & 3, t0 = b * SEQ + c * 64, ch0 = h * 128;
    float kk[2][8];
    __syncthreads();
    hgrn_prep(pre, lds, tid, kk);
    LAS float* BL = (LAS float*)(lds + HL_BL);
    LAS unsigned short* KT = (LAS unsigned short*)(lds + HL_KT); LAS unsigned short* VT = (LAS unsigned short*)(lds + HL_VT);
    const int c8 = tid & 15;
    float bl[8];
    { const f32x4 a = *(const LAS f32x4*)(BL + 63 * 128 + 8 * c8), bq = *(const LAS f32x4*)(BL + 63 * 128 + 8 * c8 + 4); bl[0] = a.x; bl[1] = a.y; bl[2] = a.z; bl[3] = a.w; bl[4] = bq.x; bl[5] = bq.y; bl[6] = bq.z; bl[7] = bq.w; }
#pragma unroll
    for (int j = 0; j < 2; ++j) { const int r = (tid >> 4) + 32 * j;
        const f32x4 b0 = *(const LAS f32x4*)(BL + r * 128 + 8 * c8), b1 = *(const LAS f32x4*)(BL + r * 128 + 8 * c8 + 4);
        const float B[8] = {b0.x, b0.y, b0.z, b0.w, b1.x, b1.y, b1.z, b1.w};
        float iv[8]; unpack8(pre.iv[j], iv);
#pragma unroll
        for (int e = 0; e < 8; ++e) { KT[(8 * c8 + e) * 72 + (r ^ ((c8 & 7) << 3))] = bf16_of(kk[j][e] * __expf(bl[e] - B[e])); VT[(8 * c8 + e) * 72 + (r ^ ((c8 & 7) << 3))] = bf16_of(iv[e]); } }
    if (tid < 128) DEC[(size_t)unit * 128 + tid] = __expf(BL[63 * 128 + tid]);
    if (next_unit < 1024) hgrn_load<false>(pre, P1, next_unit, tid);
    __syncthreads();
    const int l16 = lane & 15, lq = lane >> 4;
    bf16x8 af[2];
#pragma unroll
    for (int ks = 0; ks < 2; ++ks) af[ks] = *(const LAS bf16x8*)(lds + HL_KT + (wave * 16 + l16) * 144 + (((ks * 4 + lq) ^ ((2 * wave + (l16 >> 3)) & 7)) << 4));
#pragma unroll
    for (int vt = 0; vt < 8; ++vt) { f32x4 acc = (f32x4){0.f, 0.f, 0.f, 0.f};
#pragma unroll
        for (int ks = 0; ks < 2; ++ks) { const bf16x8 bfr = *(const LAS bf16x8*)(lds + HL_VT + (vt * 16 + l16) * 144 + (((ks * 4 + lq) ^ ((2 * vt + (l16 >> 3)) & 7)) << 4));
            acc = MFMA_H(af[ks], bfr, acc); }
        u32x2 w; w.x = cvt_pk_h(acc[0], acc[1]); w.y = cvt_pk_h(acc[2], acc[3]);
        *(u32x2*)(ST + ((size_t)unit * 128 + vt * 16 + l16) * 128 + wave * 16 + 4 * lq) = w; }
}

__device__ __forceinline__ void hgrn_pass3(const bf16_t* P1, HPre& pre, int next_unit, const bf16_t* ST, const float* gout_l, bf16_t* ZA, LAS unsigned char* lds, int unit, int tid, int wave, int lane) {
    const int bh = unit >> 5, c = unit & 31, b = bh >> 2, h = bh & 3, t0 = b * SEQ + c * 64, ch0 = h * 128;
    float kk[2][8];
    __syncthreads();
    hgrn_prep(pre, lds, tid, kk);
    LAS float* BL = (LAS float*)(lds + HL_BL);
    LAS unsigned short* VT = (LAS unsigned short*)(lds + HL_VT);
    const int c8 = tid & 15;
    float rf[8];
    { const f32x4 a = *(const LAS f32x4*)(BL + 31 * 128 + 8 * c8), bq = *(const LAS f32x4*)(BL + 31 * 128 + 8 * c8 + 4); rf[0] = a.x; rf[1] = a.y; rf[2] = a.z; rf[3] = a.w; rf[4] = bq.x; rf[5] = bq.y; rf[6] = bq.z; rf[7] = bq.w; }
#pragma unroll
    for (int j = 0; j < 2; ++j) { const int r = (tid >> 4) + 32 * j;
        const f32x4 b0 = *(const LAS f32x4*)(BL + r * 128 + 8 * c8), b1 = *(const LAS f32x4*)(BL + r * 128 + 8 * c8 + 4);
        const float B[8] = {b0.x, b0.y, b0.z, b0.w, b1.x, b1.y, b1.z, b1.w};
        float q[8]; unpack8(*(const u32x4*)(P1 + (size_t)(t0 + r) * NP1 + ch0 + 8 * c8), q);
        float iv[8]; unpack8(pre.iv[j], iv);
        float a1[8], bk[8], qh[8];
#pragma unroll
        for (int e = 0; e < 8; ++e) { const float d = B[e] - rf[e]; a1[e] = q[e] * __expf(fminf(d, 80.f)); bk[e] = kk[j][e] * __expf(fminf(-d, 80.f)); qh[e] = q[e] * __expf(B[e]); VT[(8 * c8 + e) * 72 + (r ^ ((c8 & 7) << 3))] = bf16_of(iv[e]); }
        *(LAS u32x4*)(lds + HL_A1 + r * 272 + 16 * c8) = pack8_truebf16(a1);
        *(LAS u32x4*)(lds + HL_BK + r * 272 + 16 * c8) = pack8_truebf16(bk);
        *(LAS u32x4*)(lds + HL_QH + r * 272 + 16 * c8) = pack8(qh); }
    if (next_unit < 1024) hgrn_load<true>(pre, P1, next_unit, tid);
    const int l16 = lane & 15, lq = lane >> 4;
    bf16x8 sf[4][4]; u32x2 gov[4];
    { const int vh_ = wave >> 2, ti_ = wave & 3;
#pragma unroll
      for (int jv = 0; jv < 4; ++jv) { const bf16_t* sp = ST + ((size_t)unit * 128 + (vh_ * 4 + jv) * 16 + l16) * 128 + 8 * lq;
#pragma unroll
          for (int k4 = 0; k4 < 4; ++k4) sf[jv][k4] = *(const bf16x8*)(sp + k4 * 32);
          gov[jv] = *(const u32x2*)(P1 + (size_t)(t0 + ti_ * 16 + l16) * NP1 + 3 * BW + ch0 + (vh_ * 4 + jv) * 16 + 4 * lq); } }
    __syncthreads();
#pragma unroll
    for (int j = 0; j < 2; ++j) { const int id = 2 * wave + j, si = id >> 2, ti = id & 3; f32x4 acc = (f32x4){0.f, 0.f, 0.f, 0.f};
#pragma unroll
        for (int k4 = 0; k4 < 4; ++k4) { const bf16x8 af = *(const LAS bf16x8*)(lds + HL_BK + (si * 16 + l16) * 272 + (k4 * 32 + 8 * lq) * 2);
            const bf16x8 bfr = *(const LAS bf16x8*)(lds + HL_A1 + (ti * 16 + l16) * 272 + (k4 * 32 + 8 * lq) * 2);
            acc = __builtin_amdgcn_mfma_f32_16x16x32_bf16(af, bfr, acc, 0, 0, 0); }
#pragma unroll
        for (int r = 0; r < 4; ++r) { const bool keep = (si < ti) || (si == ti && 4 * lq + r <= l16); acc[r] = keep ? acc[r] : 0.f; }
        u32x2 w; w.x = cvt_pk_h(acc[0], acc[1]); w.y = cvt_pk_h(acc[2], acc[3]);
        *(LAS u32x2*)(lds + HL_P + (ti * 16 + l16) * 144 + (si * 16 + 4 * lq) * 2) = w; }
    __syncthreads();
    const int ti = wave & 3, vh = wave >> 2;
    f32x4 o[4]; float ss = 0.f;
    bf16x8 pf[2], qf[4];
#pragma unroll
    for (int ks = 0; ks < 2; ++ks) pf[ks] = *(const LAS bf16x8*)(lds + HL_P + (ti * 16 + l16) * 144 + (ks * 32 + 8 * lq) * 2);
#pragma unroll
    for (int k4 = 0; k4 < 4; ++k4) qf[k4] = *(const LAS bf16x8*)(lds + HL_QH + (ti * 16 + l16) * 272 + (k4 * 32 + 8 * lq) * 2);
#pragma unroll
    for (int jv = 0; jv < 4; ++jv) { const int vt = vh * 4 + jv; f32x4 acc = (f32x4){0.f, 0.f, 0.f, 0.f};
#pragma unroll
        for (int ks = 0; ks < 2; ++ks) { const bf16x8 af = *(const LAS bf16x8*)(lds + HL_VT + (vt * 16 + l16) * 144 + (((ks * 4 + lq) ^ ((2 * vt + (l16 >> 3)) & 7)) << 4));
            acc = MFMA_H(af, pf[ks], acc); }
#pragma unroll
        for (int k4 = 0; k4 < 4; ++k4) acc = MFMA_H(sf[jv][k4], qf[k4], acc);
        o[jv] = acc; ss += (acc[0] * acc[0] + acc[1] * acc[1]) + (acc[2] * acc[2] + acc[3] * acc[3]); }
    ss += __shfl_xor(ss, 16); ss += __shfl_xor(ss, 32);
    LAS float* RS = (LAS float*)(lds + HL_RS);
    if (lq == 0) RS[vh * 64 + ti * 16 + l16] = ss;
    __syncthreads();
    const float rstd = rsqrtf((RS[ti * 16 + l16] + RS[64 + ti * 16 + l16]) * (1.0f / 128.0f) + NORM_EPS);
    const int trow = t0 + ti * 16 + l16;
#pragma unroll
    for (int jv = 0; jv < 4; ++jv) { const int v = (vh * 4 + jv) * 16 + 4 * lq;
        const f32x4 g4 = *(const f32x4*)(gout_l + ch0 + v);
        const u32x2 go = gov[jv];
        const f32x4 r = o[jv] * rstd * g4 * (f32x4){h_lo(go.x), h_hi(go.x), h_lo(go.y), h_hi(go.y)};
        u32x2 w; w.x = cvt_pk_h(r[0], r[1]); w.y = cvt_pk_h(r[2], r[3]);
        *(u32x2*)(ZA + (size_t)trow * BW + ch0 + v) = w; }
}

__device__ __forceinline__ void hgrn_scan(const bf16_t* SL, bf16_t* ST, const float* DEC, int gtid, int nthreads) {
    for (int it = gtid; it < 32 * 128 * 32; it += nthreads) {
        const int bh = it >> 12, rem = it & 4095, v = rem >> 5, k4 = (rem & 31) * 4;
        const bf16_t* lp = SL + ((size_t)(bh * 32) * 128 + v) * 128 + k4; bf16_t* sp = ST + ((size_t)(bh * 32) * 128 + v) * 128 + k4; const float* dp = DEC + (size_t)(bh * 32) * 128 + k4;
        u32x2 Lv[32];
#pragma unroll
        for (int c = 0; c < 32; ++c) Lv[c] = *(const u32x2*)(lp + (size_t)c * 128 * 128);
        f32x4 S = (f32x4){0.f, 0.f, 0.f, 0.f};
#pragma unroll
        for (int c0 = 0; c0 < 32; c0 += 8) { f32x4 dv[8];
#pragma unroll
            for (int j = 0; j < 8; ++j) dv[j] = *(const f32x4*)(dp + (size_t)(c0 + j) * 128);
#pragma unroll
            for (int j = 0; j < 8; ++j) { u32x2 w; w.x = cvt_pk_h(S[0], S[1]); w.y = cvt_pk_h(S[2], S[3]);
                *(u32x2*)(sp + (size_t)(c0 + j) * 128 * 128) = w;
                S = dv[j] * S + (f32x4){h_lo(Lv[c0 + j].x), h_hi(Lv[c0 + j].x), h_lo(Lv[c0 + j].y), h_hi(Lv[c0 + j].y)}; } }
    }
}

__device__ __forceinline__ void conv_phase(const bf16_t* P1, const float* wconv_l, bf16_t* ZB, int gtid, int nthreads) {
    for (int it = gtid; it < (T / 4) * 64; it += nthreads) {
        const int c8 = it & 63, t = (it >> 6) * 4; const bool head = ((t & (SEQ - 1)) == 0);
        u32x4 cgr[6], xcr[6], bgr[4];
#pragma unroll
        for (int i = 0; i < 6; ++i) { const int row = (i < 2 && head) ? t : (t - 2 + i); const bf16_t* rp = P1 + (size_t)row * NP1 + 8 * c8; cgr[i] = *(const u32x4*)(rp + 5 * BW); xcr[i] = *(const u32x4*)(rp + 6 * BW); }
#pragma unroll
        for (int o = 0; o < 4; ++o) bgr[o] = *(const u32x4*)(P1 + (size_t)(t + o) * NP1 + 4 * BW + 8 * c8);
        float wc[3][8];
#pragma unroll
        for (int j = 0; j < 3; ++j) { const f32x4 a = *(const f32x4*)(wconv_l + j * BW + 8 * c8), bq = *(const f32x4*)(wconv_l + j * BW + 8 * c8 + 4);
            wc[j][0] = a.x; wc[j][1] = a.y; wc[j][2] = a.z; wc[j][3] = a.w; wc[j][4] = bq.x; wc[j][5] = bq.y; wc[j][6] = bq.z; wc[j][7] = bq.w; }
        float z[6][8];
#pragma unroll
        for (int i = 0; i < 6; ++i) { float cgv[8], xcv[8]; unpack8(cgr[i], cgv); unpack8(xcr[i], xcv); const bool zero = (i < 2 && head);
#pragma unroll
            for (int e = 0; e < 8; ++e) z[i][e] = zero ? 0.f : cgv[e] * xcv[e]; }
#pragma unroll
        for (int o = 0; o < 4; ++o) { float bg[8]; unpack8(bgr[o], bg); float y[8];
#pragma unroll
            for (int e = 0; e < 8; ++e) y[e] = bg[e] * (wc[0][e] * z[o][e] + wc[1][e] * z[o + 1][e] + wc[2][e] * z[o + 2][e]);
            *(u32x4*)(ZB + (size_t)(t + o) * BW + 8 * c8) = pack8(y); }
    }
}

constexpr int SG_VT = 0;
__device__ __forceinline__ void sg_unit(const bf16_t* P1, const float* lng, const float* lnb, const float* wsg_l, const float* bsg_l, bf16_t* ZC, LAS unsigned char* lds, int unit, int wave, int lane) {
    const int ci = unit >> 2, g = unit & 3, t0 = ci * 128;
    LAS unsigned short* VT = (LAS unsigned short*)(lds + SG_VT);
    __syncthreads();
    const bool mine = ((lane >> 4) == g); const int d0 = (lane & 15) * 8;
    float lg[8], lb[8];
    { const f32x4 a = *(const f32x4*)(lng + g * 128 + d0), bq = *(const f32x4*)(lng + g * 128 + d0 + 4), cq = *(const f32x4*)(lnb + g * 128 + d0), dq = *(const f32x4*)(lnb + g * 128 + d0 + 4);
      lg[0] = a.x; lg[1] = a.y; lg[2] = a.z; lg[3] = a.w; lg[4] = bq.x; lg[5] = bq.y; lg[6] = bq.z; lg[7] = bq.w; lb[0] = cq.x; lb[1] = cq.y; lb[2] = cq.z; lb[3] = cq.w; lb[4] = dq.x; lb[5] = dq.y; lb[6] = dq.z; lb[7] = dq.w; }
    const int l16 = lane & 15, lq = lane >> 4, t = wave * 16 + l16, nk = (wave >> 1) + 1;
    f32x4 wraw[4][2]; u32x2 uu8[8];
    { const float* wrow = wsg_l + ((size_t)g * 128 + t) * 128 + 8 * lq;
#pragma unroll
      for (int k4 = 0; k4 < 4; ++k4) { if (k4 < nk) { wraw[k4][0] = *(const f32x4*)(wrow + k4 * 32); wraw[k4][1] = *(const f32x4*)(wrow + k4 * 32 + 4); } else { wraw[k4][0] = (f32x4){0.f, 0.f, 0.f, 0.f}; wraw[k4][1] = wraw[k4][0]; } }
#pragma unroll
      for (int jd = 0; jd < 8; ++jd) uu8[jd] = *(const u32x2*)(P1 + (size_t)(t0 + t) * NP1 + 7 * BW + g * 128 + jd * 16 + 4 * lq); }
    const float bs = bsg_l[g * 128 + t];
    u32x4 xr[16];
#pragma unroll
    for (int i = 0; i < 16; ++i) xr[i] = *(const u32x4*)(P1 + (size_t)(t0 + wave + 8 * i) * NP1 + 8 * BW + 8 * lane);
#pragma unroll
    for (int i = 0; i < 16; ++i) { const int r = wave + 8 * i;
        float x[8]; unpack8(xr[i], x);
        float s = ((x[0] + x[1]) + (x[2] + x[3])) + ((x[4] + x[5]) + (x[6] + x[7]));
        const float mean = wave_sum(s) * (1.0f / BW); float q = 0.f;
#pragma unroll
        for (int e = 0; e < 8; ++e) { x[e] -= mean; q += x[e] * x[e]; }
        const float rstd = rsqrtf(wave_sum(q) * (1.0f / BW) + LN_EPS);
        if (mine) {
#pragma unroll
            for (int e = 0; e < 8; ++e) VT[(d0 + e) * 136 + (r ^ ((lane & 15) << 3))] = bf16_of(x[e] * rstd * lg[e] + lb[e]); } }
    __syncthreads();
    bf16x8 wf[4];
#pragma unroll
    for (int k4 = 0; k4 < 4; ++k4) { float w[8] = {wraw[k4][0].x, wraw[k4][0].y, wraw[k4][0].z, wraw[k4][0].w, wraw[k4][1].x, wraw[k4][1].y, wraw[k4][1].z, wraw[k4][1].w};
#pragma unroll
        for (int e = 0; e < 8; ++e) w[e] = (k4 * 32 + 8 * lq + e <= t) ? w[e] : 0.f;
        const u32x4 pk = pack8(w); wf[k4] = __builtin_bit_cast(bf16x8, pk); }
#pragma unroll
    for (int jd = 0; jd < 8; ++jd) { f32x4 acc = (f32x4){0.f, 0.f, 0.f, 0.f};
#pragma unroll
        for (int k4 = 0; k4 < 4; ++k4) { const bf16x8 af = *(const LAS bf16x8*)(lds + SG_VT + (jd * 16 + l16) * 272 + (((k4 * 4 + lq) ^ ((2 * jd + (l16 >> 3)) & 15)) << 4));
            acc = MFMA_H(af, wf[k4], acc); }
        const int d = jd * 16 + 4 * lq;
        const u32x2 uu = uu8[jd];
        const f32x4 r = (acc + bs) * (f32x4){h_lo(uu.x), h_hi(uu.x), h_lo(uu.y), h_hi(uu.y)};
        u32x2 w; w.x = cvt_pk_h(r[0], r[1]); w.y = cvt_pk_h(r[2], r[3]);
        *(u32x2*)(ZC + (size_t)(t0 + t) * BW + g * 128 + d) = w; }
}

#define XB_TMO      128
#define XB_XCNT(j)  (256  + 64 * (j))
#define XB_XSUB(j)  (1280 + 64 * (j))
#define XB_XGEN(j)  (2304 + 64 * (j))
#define XB_TOP      3328
#define XB_TOPGEN   3392
#define XCD_BAR_WORDS 3456
#define XB_SPIN_CAP (1u << 18)

__device__ __forceinline__ unsigned xb_ld(unsigned* p)              { return __hip_atomic_load(p, __ATOMIC_RELAXED, __HIP_MEMORY_SCOPE_AGENT); }
__device__ __forceinline__ unsigned xb_add(unsigned* p, unsigned v) { return __hip_atomic_fetch_add(p, v, __ATOMIC_RELAXED, __HIP_MEMORY_SCOPE_AGENT); }
__device__ __forceinline__ unsigned xb_xcc_id() { return (unsigned)__builtin_amdgcn_s_getreg((3 << 11) | 20) & 0xFu; }
#define XB_SPIN(cond, bar) do { unsigned _sp = 0; while (cond) { __builtin_amdgcn_s_sleep(1); \
    if ((++_sp & 255u) == 0u) { if (xb_ld(&(bar)[XB_TMO])) break; if (_sp > XB_SPIN_CAP) { atomicAdd(&(bar)[XB_TMO], 1u); break; } } } } while (0)

struct XcdBarrier {
    unsigned* bar; unsigned x;
    volatile LAS unsigned* st;
};

__device__ __forceinline__ XcdBarrier xcd_barrier_post(unsigned* bar, volatile LAS unsigned* st) {
    XcdBarrier b; b.bar = bar; b.x = xb_xcc_id(); b.st = st;
    if (threadIdx.x == 0) (void)xb_add(&bar[XB_XCNT(b.x)], 1u);
    return b;
}
__device__ __forceinline__ void xcd_barrier_complete(unsigned* bar, unsigned x, unsigned& nloc, unsigned& nx) {
    const unsigned G = gridDim.x * gridDim.y * gridDim.z;
    unsigned sum, cnt, mine, sp = 0u;
    for (;;) {
        sum = 0u; cnt = 0u; mine = 0u;
#pragma unroll
        for (unsigned j = 0; j < 16; ++j) { const unsigned c = xb_ld(&bar[XB_XCNT(j)]); sum += c; cnt += (c > 0u) ? 1u : 0u; mine = (j == x) ? c : mine; }
        if (sum == G) break;
        __builtin_amdgcn_s_sleep(1);
        if ((++sp & 255u) == 0u) { if (xb_ld(&bar[XB_TMO])) break; if (sp > XB_SPIN_CAP) { atomicAdd(&bar[XB_TMO], 1u); break; } }
    }
    nloc = mine > 0u ? mine : 1u; nx = cnt > 0u ? cnt : 1u;
}

__device__ __forceinline__ void xcd_barrier(const XcdBarrier& b) {
    asm volatile("s_waitcnt vmcnt(0)" ::: "memory");
    __syncthreads();
    if (threadIdx.x == 0) {
        unsigned* bar = b.bar;
        __builtin_amdgcn_s_waitcnt(0);
        unsigned nloc = b.st[0], nx = b.st[1];
        if (nloc == 0u) { xcd_barrier_complete(bar, b.x, nloc, nx); b.st[0] = nloc; b.st[1] = nx; }
        const unsigned old = xb_add(&bar[XB_XSUB(b.x)], 1u);
        const unsigned gen = old / nloc;
        if (old + 1u == (gen + 1u) * nloc) {
            __builtin_amdgcn_fence(__ATOMIC_RELEASE, "agent");
            asm volatile("s_waitcnt vmcnt(0)" ::: "memory");
            const unsigned og = xb_add(&bar[XB_TOP], 1u);
            const unsigned tg = og / nx;
            if (og + 1u == (tg + 1u) * nx) xb_add(&bar[XB_TOPGEN], 1u);
            else XB_SPIN(xb_ld(&bar[XB_TOPGEN]) == tg, bar);
            __builtin_amdgcn_fence(__ATOMIC_ACQUIRE, "agent");
            xb_add(&bar[XB_XGEN(b.x)], 1u);
            asm volatile("s_waitcnt vmcnt(0)" ::: "memory");
        } else {
            XB_SPIN(xb_ld(&bar[XB_XGEN(b.x)]) == gen, bar);
            __builtin_amdgcn_fence(__ATOMIC_ACQUIRE, "agent");
            asm volatile("s_waitcnt vmcnt(0)" ::: "memory");
        }
    }
    __syncthreads();
}

__global__ void __launch_bounds__(512, 2) mk_fwd(Args a) {
    extern __shared__ __attribute__((aligned(16))) unsigned char lds_raw[];
    LAS unsigned char* lds = (LAS unsigned char*)lds_raw;
    cg::grid_group grid = cg::this_grid();
    if (threadIdx.x < 16) ((LAS unsigned*)(lds + LDS_BARST))[threadIdx.x] = 0u;
    __syncthreads();
    XcdBarrier xbar = xcd_barrier_post((unsigned*)(a.ws + WS_BAR), (volatile LAS unsigned*)(lds + LDS_BARST));
    const int lo = a.ph_lo, hi = a.ph_hi;
    if (lo < 0) grid.sync();
#define IN(k) (lo <= (k) && (k) < hi)
#define SEAM(k) do { if (IN(k) && IN((k) + 1)) xcd_barrier(xbar); } while (0)
#define PHASE_ENV \
    size_t zoff_ = 0; asm volatile("" : "+s"(zoff_)); unsigned char* ws = a.ws + zoff_;     \
    int tid = threadIdx.x; asm volatile("" : "+v"(tid)); \
    int G = gridDim.x, bx = blockIdx.x; asm volatile("" : "+s"(G), "+s"(bx)); \
    const int lane = tid & 63, wave = __builtin_amdgcn_readfirstlane(tid >> 6); \
    const int vcu = (G % 8 == 0) ? (bx % 8) * (G / 8) + bx / 8 : bx; \
    (void)lane; (void)wave; (void)vcu;
    for (int rep_ = 0; rep_ < MK_REP_PRO; ++rep_) { if (IN(0)) { PHASE_ENV; prologue(a, lds, wave, lane, vcu, G); } if (rep_ + 1 < MK_REP_PRO) { asm volatile("s_waitcnt vmcnt(0)" ::: "memory"); __syncthreads(); } }
    SEAM(0);
    for (int l = 0; l < MK_DBG_LAYERS; ++l) {
        const int p0 = 1 + 8 * l;
        for (int rep_ = 0; rep_ < MK_REP_A; ++rep_) {
        if (IN(p0) && MK_DBG_PH > 0) {
            PHASE_ENV;
            pg8::StaticOrder S; S.init(ws + WS_XB, (const bf16_t*)(ws + WS_WIN) + (size_t)l * NIN * D, T, NIN, D, G, bx);
            pg8::EpiA E{(bf16_t*)(ws + WS_P1), (bf16_t*)(ws + WS_G), (const float*)(ws + WS_RSS), (const float*)(ws + WS_LBS) + l * BW};
            pg8::gemm_phase(lds, tid, D, S, E);
        }
        if (IN(p0) && MK_DBG_PH > 0 && l + 1 < DEPTH && rep_ == 0) {
            PHASE_ENV;
            if (G == 256) { if (bx >= 128) convert_layer(a, ws, l + 1, (bx - 128) * 8 + wave, 1024, (LAS float*)(lds + wave * 16640), lane); }
            else convert_layer(a, ws, l + 1, vcu * 8 + wave, G * 8, (LAS float*)(lds + wave * 16640), lane);
        }
        SEAM(p0);
        }
        for (int rep_ = 0; rep_ < MK_REP_B1; ++rep_) {
        if (IN(p0 + 1) && MK_DBG_PH > 1) {
            PHASE_ENV;
            const bf16_t* P1 = (const bf16_t*)(ws + WS_P1);
            { HPre pre; hgrn_load<false>(pre, P1, vcu, tid);
              for (int u = vcu; u < 1024; u += G) hgrn_pass1(P1, pre, u + G, (bf16_t*)(ws + WS_SL), (float*)(ws + WS_DEC), lds, u, tid, wave, lane); }
            for (int u = vcu; u < 512; u += G) sg_unit(P1, a.sg_ln_g + l * BW, a.sg_ln_b + l * BW, a.w_sg + (size_t)l * 4 * 128 * 128, a.b_sg + l * 4 * 128, (bf16_t*)(ws + WS_ZC), lds, u, wave, lane);
        }
        SEAM(p0 + 1);
        }
        for (int rep_ = 0; rep_ < MK_REP_B2; ++rep_) {
        if (IN(p0 + 2) && MK_DBG_PH > 2) {
            PHASE_ENV;
            hgrn_scan((const bf16_t*)(ws + WS_SL), (bf16_t*)(ws + WS_ST), (const float*)(ws + WS_DEC), vcu * 512 + tid, G * 512);
        }
        SEAM(p0 + 2);
        }
        for (int rep_ = 0; rep_ < MK_REP_B3; ++rep_) {
        if (IN(p0 + 3) && MK_DBG_PH > 3) {
            PHASE_ENV;
            { const bf16_t* P1 = (const bf16_t*)(ws + WS_P1); HPre pre; hgrn_load<true>(pre, P1, vcu, tid);
              for (int u = vcu; u < 1024; u += G) hgrn_pass3(P1, pre, u + G, (const bf16_t*)(ws + WS_ST), a.g_hgrn_out + l * BW, (bf16_t*)(ws + WS_ZA), lds, u, tid, wave, lane); }
            __syncthreads();
            conv_phase((const bf16_t*)(ws + WS_P1), a.w_conv + (size_t)l * 3 * BW, (bf16_t*)(ws + WS_ZB), vcu * 512 + tid, G * 512);
        }
        SEAM(p0 + 3);
        }
        for (int rep_ = 0; rep_ < MK_REP_C; ++rep_) {
        if (IN(p0 + 4) && MK_DBG_PH > 4) {
            PHASE_ENV;
            pg8::BranchOrder S; S.init(ws + WS_ZA, (size_t)(WS_ZB - WS_ZA), (const bf16_t*)(ws + WS_WBR) + (size_t)l * 3 * D * BW, G, bx);
            pg8::EpiC E{(const bf16_t*)(ws + WS_G), (bf16_t*)(ws + WS_MB)};
            pg8::gemm_phase(lds, tid, BW, S, E);
        }
        SEAM(p0 + 4);
        }
        for (int repd_ = 0; repd_ < MK_REP_D; ++repd_) {
        if (IN(p0 + 5) && MK_DBG_PH > 5) {
            PHASE_ENV;
            pg8::StaticOrder S; S.init(ws + WS_MB, (const bf16_t*)(ws + WS_WO) + (size_t)l * D * D, T, D, D, G, bx);
            pg8::EpiRes E{l == 0 ? a.x : (const float*)a.out, a.out, (bf16_t*)(ws + WS_XB), (float*)(ws + WS_RSS), repd_ + 1 < MK_REP_D};
            pg8::gemm_phase(lds, tid, D, S, E);
        }
        SEAM(p0 + 5);
        }
        for (int rep_ = 0; rep_ < MK_REP_E; ++rep_) {
        if (IN(p0 + 6) && MK_DBG_PH > 6) {
            PHASE_ENV;
            pg8::StaticOrder S; S.init(ws + WS_XB, (const bf16_t*)(ws + WS_W1) + (size_t)l * FF * D, T, FF, D, G, bx);
            pg8::EpiE E{(bf16_t*)(ws + WS_H), (const float*)(ws + WS_RSS)};
            pg8::gemm_phase(lds, tid, D, S, E);
        }
        SEAM(p0 + 6);
        }
        for (int repd_ = 0; repd_ < MK_REP_F; ++repd_) {
        if (IN(p0 + 7) && MK_DBG_PH > 7) {
            PHASE_ENV;
            pg8::StaticOrder S; S.init(ws + WS_H, (const bf16_t*)(ws + WS_W2) + (size_t)l * D * FF, T, D, FF, G, bx);
            pg8::EpiRes E{a.out, a.out, (bf16_t*)(ws + WS_XB), (float*)(ws + WS_RSS), repd_ + 1 < MK_REP_F};
            pg8::gemm_phase(lds, tid, FF, S, E);
        }
        SEAM(p0 + 7);
        }
        for (int rep_ = 0; rep_ < MK_EXTRA_SYNC; ++rep_) SEAM(p0 + 7);
    }
    if (IN(NPH - 1)) {
        PHASE_ENV;
        const float* rss = (const float*)(ws + WS_RSS); float* X = a.out;
        const int gw = vcu * 8 + wave, NGW = G * 8;
        for (int m = gw; m < T; m += NGW) { const float rs = row_rs(rss, m);
            f32x4* xo = (f32x4*)(X + (size_t)m * D) + lane; const f32x4* gf = (const f32x4*)a.g_final + lane;
#pragma unroll
            for (int j = 0; j < 4; ++j) xo[64 * j] = xo[64 * j] * rs * gf[64 * j]; }
    }
#undef IN
#undef SEAM
}

extern "C" void kernel_launch(void* const* d_in, const int* in_sizes, int n_in, void* d_out, int out_size, void* d_ws, size_t ws_size, hipStream_t stream) {
    static int grid = 0;
    if (grid == 0) {
        if (n_in != 16 || in_sizes[0] != T * D || out_size != T * D || ws_size < WS_END) { fprintf(stderr, "kernel_launch: unexpected shapes (n_in %d, in0 %d, out %d, ws %zu < %zu)\n", n_in, n_in > 0 ? in_sizes[0] : -1, out_size, ws_size, (size_t)WS_END); grid = -1; return; }
        int dev = 0, cus = 0, per_cu = 0;
        hipGetDevice(&dev); hipDeviceGetAttribute(&cus, hipDeviceAttributeMultiprocessorCount, dev);
        if (hipFuncSetAttribute((const void*)mk_fwd, hipFuncAttributeMaxDynamicSharedMemorySize, LDS_BYTES) != hipSuccess) { fprintf(stderr, "kernel_launch: hipFuncSetAttribute failed\n"); grid = -1; return; }
        if (hipOccupancyMaxActiveBlocksPerMultiprocessor(&per_cu, (const void*)mk_fwd, 512, LDS_BYTES) != hipSuccess || per_cu < 1) { fprintf(stderr, "kernel_launch: occupancy query says %d\n", per_cu); per_cu = 1; }
        (void)hipGetLastError();
        grid = cus * 1;
    }
    if (grid < 0) return;
    if (hipMemsetAsync((char*)d_ws + WS_BAR, 0, BAR_ZERO_BYTES, stream) != hipSuccess) { fprintf(stderr, "kernel_launch: memset failed\n"); return; }
    Args a{};
    a.x = (const float*)d_in[0]; a.w_in = (const float*)d_in[1]; a.g_mix = (const float*)d_in[2]; a.lower_bounds = (const float*)d_in[3]; a.g_hgrn_out = (const float*)d_in[4];
    a.w_conv = (const float*)d_in[5]; a.sg_ln_g = (const float*)d_in[6]; a.sg_ln_b = (const float*)d_in[7]; a.w_sg = (const float*)d_in[8]; a.b_sg = (const float*)d_in[9];
    a.w_branch = (const float*)d_in[10]; a.w_o = (const float*)d_in[11]; a.g_ffn = (const float*)d_in[12]; a.w_ff1 = (const float*)d_in[13]; a.w_ff2 = (const float*)d_in[14]; a.g_final = (const float*)d_in[15];
    a.out = (float*)d_out; a.ws = (unsigned char*)d_ws;
    a.ph_lo = 0; a.ph_hi = NPH;
    { void* args[] = {&a}; hipError_t e = hipLaunchCooperativeKernel((const void*)mk_fwd, dim3(grid), dim3(512), args, LDS_BYTES, stream);
      if (e != hipSuccess) fprintf(stderr, "cooperative launch failed: %s (grid %d)\n", hipGetErrorString(e), grid); }
}
```

```cpp
#include <hip/hip_runtime.h>
#include <hip/hip_cooperative_groups.h>
#include <cstdio>
#include <cstdint>
namespace cg = cooperative_groups;

#ifndef MK_DBG_LAYERS
#define MK_DBG_LAYERS 4
#endif
#ifndef MK_DBG_PH
#define MK_DBG_PH 8
#endif
#ifndef MK_REP_B1
#define MK_REP_B1 1
#endif
#ifndef MK_REP_B2
#define MK_REP_B2 1
#endif
#ifndef MK_REP_B3
#define MK_REP_B3 1
#endif
#ifndef MK_REP_A
#define MK_REP_A 1
#endif
#ifndef MK_REP_C
#define MK_REP_C 1
#endif
#ifndef MK_REP_E
#define MK_REP_E 1
#endif
#ifndef MK_EXTRA_SYNC
#define MK_EXTRA_SYNC 0
#endif
#ifndef MK_REP_PRO
#define MK_REP_PRO 1
#endif
#ifndef MK_REP_D
#define MK_REP_D 1
#endif
#ifndef MK_REP_F
#define MK_REP_F 1
#endif

#define LAS __attribute__((address_space(3)))
typedef unsigned short bf16_t;
typedef short bf16x8 __attribute__((ext_vector_type(8)));
typedef float f32x4 __attribute__((ext_vector_type(4)));
typedef float f32x2 __attribute__((ext_vector_type(2)));
typedef unsigned u32x4 __attribute__((ext_vector_type(4)));
typedef unsigned u32x2 __attribute__((ext_vector_type(2)));

constexpr int T = 16384, D = 1024, BW = 512, NIN = 7680, FF = 4096, DEPTH = 4, SEQ = 2048;
constexpr int NP1 = 4608, NG = 3072;
constexpr float NORM_EPS = 1e-6f, LN_EPS = 1e-5f;
constexpr size_t MiB = 1u << 20;
constexpr size_t WS_LBS = 64 * 1024, WS_RSS = 128 * 1024, WS_DEC = 1280 * 1024;
constexpr size_t WS_WIN = 2 * MiB, WS_WBR = 62 * MiB, WS_WO = 74 * MiB, WS_W1 = 82 * MiB, WS_W2 = 114 * MiB;
constexpr size_t WS_XB = 146 * MiB, WS_ZA = 146 * MiB, WS_ZB = 162 * MiB, WS_ZC = 178 * MiB;
constexpr size_t WS_P1 = 194 * MiB, WS_H = 194 * MiB, WS_MS = 194 * MiB, WS_G = 338 * MiB, WS_MB = 434 * MiB, WS_ST = 434 * MiB, WS_SL = 146 * MiB, WS_END = 466 * MiB;
constexpr int LDS_BYTES = 147456;
constexpr int LDS_BARST = 147392;
constexpr size_t WS_BAR = 0, BAR_ZERO_BYTES = 16384;
constexpr int NPH = 2 + 8 * DEPTH;

typedef __bf16 bf16v2_t __attribute__((ext_vector_type(2)));
typedef _Float16 h16v2_t __attribute__((ext_vector_type(2)));
typedef _Float16 h16x8 __attribute__((ext_vector_type(8)));
__device__ __forceinline__ unsigned cvt_pk_truebf16(float lo, float hi) { bf16v2_t v; v.x = (__bf16)lo; v.y = (__bf16)hi; return __builtin_bit_cast(unsigned, v); }
__device__ __forceinline__ unsigned cvt_pk_h(float lo, float hi) { h16v2_t v; v.x = (_Float16)lo; v.y = (_Float16)hi; return __builtin_bit_cast(unsigned, v); }
__device__ __forceinline__ float h_lo(unsigned w) { return (float)__builtin_bit_cast(h16v2_t, w).x; }
__device__ __forceinline__ float h_hi(unsigned w) { return (float)__builtin_bit_cast(h16v2_t, w).y; }
#define MFMA_H(a, b, c) __builtin_amdgcn_mfma_f32_16x16x32_f16(__builtin_bit_cast(h16x8, (a)), __builtin_bit_cast(h16x8, (b)), (c), 0, 0, 0)
__device__ __forceinline__ float fast_sigmoid(float x) { return __builtin_amdgcn_rcpf(1.0f + __expf(-x)); }
#define DPP_ADD(v, ctrl) ((v) + __builtin_bit_cast(float, __builtin_amdgcn_update_dpp(0, __builtin_bit_cast(int, (v)), (ctrl), 0xf, 0xf, true)))
__device__ __forceinline__ float wave_sum(float v) {
    v = DPP_ADD(v, 0xB1); v = DPP_ADD(v, 0x4E); v = DPP_ADD(v, 0x124); v = DPP_ADD(v, 0x128);
    const int iv = __builtin_bit_cast(int, v);
    const float r0 = __builtin_bit_cast(float, __builtin_amdgcn_readlane(iv, 0)), r1 = __builtin_bit_cast(float, __builtin_amdgcn_readlane(iv, 16)), r2 = __builtin_bit_cast(float, __builtin_amdgcn_readlane(iv, 32)), r3 = __builtin_bit_cast(float, __builtin_amdgcn_readlane(iv, 48));
    return (r0 + r1) + (r2 + r3);
}
__device__ __forceinline__ float row_rs(const float* rss, int row) {
    const f32x4* p = (const f32x4*)(rss + (size_t)row * 16);
    const f32x4 a = p[0], b = p[1], c = p[2], d = p[3];
    const float s = ((a.x + a.y) + (a.z + a.w)) + ((b.x + b.y) + (b.z + b.w)) + ((c.x + c.y) + (c.z + c.w)) + ((d.x + d.y) + (d.z + d.w));
    return rsqrtf(s * (1.0f / D) + NORM_EPS);
}
__device__ __forceinline__ float row_rs4(const float* rss, int row, int fq) {
    const f32x4 a = *(const f32x4*)(rss + (size_t)row * 16 + 4 * fq);
    float s = (a.x + a.y) + (a.z + a.w);
    s += __shfl_xor(s, 16); s += __shfl_xor(s, 32);
    return rsqrtf(s * (1.0f / D) + NORM_EPS);
}

namespace pg8 {
constexpr int BM = 256, BK = 64, HALF = 128, HTB = HALF * BK * 2, STAGE_BYTES = 8 * HTB, NXCD = 8, WGM = 8;
__host__ __device__ __forceinline__ int lds_byte(int r, int c) { const int st = (r >> 4) * 2 + (c >> 5), rr = r & 15, cc = c & 31, ob = rr * 64 + cc * 2; return st * 1024 + (ob ^ (((ob >> 9) & 1) << 5)); }
__host__ __device__ __forceinline__ void stage_rc(int b, int& R, int& C) { const int st = b / 1024, sb = b % 1024, swz = sb ^ (((sb >> 9) & 1) << 5); R = (st >> 1) * 16 + swz / 64; C = (st & 1) * 32 + (swz % 64) / 2; }
__host__ __device__ __forceinline__ int perm32(int rho) { const int n = rho >> 4, i = rho & 15; return 8 * (i >> 2) + 4 * n + (i & 3); }

struct Unit { int pm, pn, br; };
__device__ __forceinline__ void tile_map(int wgid, int nM, int nN, int& pm, int& pn) {
    const int nwg = nM * nN;
    { const int q = nwg / NXCD, r = nwg % NXCD, xcd = wgid % NXCD, off = wgid / NXCD; wgid = (xcd < r ? xcd * (q + 1) : r * (q + 1) + (xcd - r) * q) + off; }
    const int nig = WGM * nN, gid = wgid / nig, fm = gid * WGM, gsz = (nM - fm) < WGM ? (nM - fm) : WGM;
    pm = fm + ((wgid % nig) % gsz); pn = (wgid % nig) / gsz;
}
struct StaticOrder {
    int nM, nN, nwg, G, c; const char* A; const char* Bt; size_t tstep;
    __device__ void init(const void* A_, const void* Bt_, int M, int N, int K, int G_, int c_) { nM = M / BM; nN = N / BM; nwg = nM * nN; G = G_; c = c_; A = (const char*)A_; Bt = (const char*)Bt_; tstep = (size_t)BM * K * 2; }
    __device__ __forceinline__ bool next(int i, Unit& u) const { const long L = (long)i * G + c; if (L >= nwg) return false; tile_map((int)L, nM, nN, u.pm, u.pn); u.br = 0; return true; }
    __device__ __forceinline__ const char* a_ptr(const Unit& u) const { return A + (size_t)u.pm * tstep; }
    __device__ __forceinline__ const char* b_ptr(const Unit& u) const { return Bt + (size_t)u.pn * tstep; }
};
struct BranchOrder {
    int nM, nN, nwg, G, c; const char* Z; const char* Wb; size_t tstep, zstride, wstride;
    __device__ void init(const void* Z_, size_t zstride_, const void* Wb_, int G_, int c_) { nM = T / BM; nN = D / BM; nwg = nM * nN; G = G_; c = c_; Z = (const char*)Z_; Wb = (const char*)Wb_; tstep = (size_t)BM * BW * 2; zstride = zstride_; wstride = (size_t)D * BW * 2; }
    __device__ __forceinline__ bool next(int i, Unit& u) const { const int r = i / 3; const long L = (long)r * G + c; if (L >= nwg) return false; tile_map((int)L, nM, nN, u.pm, u.pn); u.br = i - 3 * r; return true; }
    __device__ __forceinline__ const char* a_ptr(const Unit& u) const { return Z + (size_t)u.br * zstride + (size_t)u.pm * tstep; }
    __device__ __forceinline__ const char* b_ptr(const Unit& u) const { return Wb + (size_t)u.br * wstride + (size_t)u.pn * tstep; }
};

template <class Epi, class Sched>
__device__ __forceinline__ void gemm_phase(LAS unsigned char* lds, const int tid, const int K, const Sched& S, const Epi& E) {
    const int wid = __builtin_amdgcn_readfirstlane(tid >> 6), lane = tid & 63, wr = wid >> 2, wc = wid & 3, fr = lane & 15, fq = lane >> 4;
    const int nt = K / BK;
    unsigned voffA[2], voffB[2];
#pragma unroll
    for (int i = 0; i < 2; ++i) { int R, C; stage_rc(tid * 16 + i * 8192, R, C); const int Rb = (R & ~31) + perm32(R & 31);
        voffA[i] = (unsigned)(R * K + C) * 2u; voffB[i] = (unsigned)(Rb * K + C) * 2u; }
    const size_t kstep = (size_t)(BK * 2);
    const size_t hstep = (size_t)HALF * K * 2;
    const unsigned ldsw = (unsigned)wid * 1024u;
    const int aoff = lds_byte(wr * 64 + fr, fq * 8), boff = lds_byte(wc * 32 + fr, fq * 8);
#define PG8_SA(b, h) (((b) * 2 + (h)) * HTB)
#define PG8_SB(b, h) ((4 + (b) * 2 + (h)) * HTB)
#define PG8_STAGE(bufoff, gbase, voff) do { _Pragma("unroll") for (int _i = 0; _i < 2; ++_i) \
        __builtin_amdgcn_global_load_lds((const unsigned*)((const char*)(gbase) + (voff)[_i]), (LAS unsigned*)(lds + (bufoff) + ldsw + _i * 8192), 16, 0, 0); } while (0)
#define PG8_LDA(dst, b, h) do { _Pragma("unroll") for (int m = 0; m < 4; ++m) _Pragma("unroll") for (int k = 0; k < 2; ++k) dst[m][k] = *(const LAS bf16x8*)(lds + PG8_SA(b, h) + aoff + m * 2048 + k * 1024); } while (0)
#define PG8_LDB(dst, b, h) do { _Pragma("unroll") for (int n = 0; n < 2; ++n) _Pragma("unroll") for (int k = 0; k < 2; ++k) dst[n][k] = *(const LAS bf16x8*)(lds + PG8_SB(b, h) + boff + n * 2048 + k * 1024); } while (0)
#define PG8_MMA(ai, bj, At, Bt) do { __builtin_amdgcn_s_setprio(1); _Pragma("unroll") for (int m = 0; m < 4; ++m) _Pragma("unroll") for (int n = 0; n < 2; ++n) _Pragma("unroll") for (int k = 0; k < 2; ++k) \
        acc[ai][bj][m][n] = MFMA_H(Bt[n][k], At[m][k], acc[ai][bj][m][n]); __builtin_amdgcn_s_setprio(0); } while (0)
#define PG8_WAIT_V(n) asm volatile("s_waitcnt vmcnt(" #n ")" ::: "memory")
#define PG8_WAIT_L(n) asm volatile("s_waitcnt lgkmcnt(" #n ")" ::: "memory")
#define PG8_BAR __builtin_amdgcn_s_barrier()
#define PG8_SCHED __builtin_amdgcn_sched_barrier(0)
    Unit cur, nxt; int ui = 0;
    if (!S.next(0, cur)) return;
    f32x4 acc[2][2][4][2];
#pragma unroll
    for (int a = 0; a < 2; ++a)
#pragma unroll
        for (int b = 0; b < 2; ++b)
#pragma unroll
            for (int m = 0; m < 4; ++m)
#pragma unroll
                for (int n = 0; n < 2; ++n) acc[a][b][m][n] = (f32x4){0.f, 0.f, 0.f, 0.f};
    bf16x8 At[4][2], B0[2][2], B1[2][2];
    const char* cA = S.a_ptr(cur); const char* cB = S.b_ptr(cur);
    PG8_STAGE(PG8_SB(0, 0), cB, voffB); PG8_STAGE(PG8_SB(0, 1), cB + hstep, voffB); PG8_STAGE(PG8_SA(0, 0), cA, voffA); PG8_STAGE(PG8_SA(0, 1), cA + hstep, voffA);
    if (wr == 1) PG8_BAR;
    PG8_WAIT_V(2); PG8_BAR;
    PG8_STAGE(PG8_SB(1, 0), cB + kstep, voffB); PG8_STAGE(PG8_SA(1, 0), cA + kstep, voffA); PG8_STAGE(PG8_SB(1, 1), cB + hstep + kstep, voffB);
    PG8_WAIT_V(6); PG8_BAR;
    for (;;) {
        const bool has_next = S.next(ui + 1, nxt);
        const char* nA = has_next ? S.a_ptr(nxt) : cA; const char* nB = has_next ? S.b_ptr(nxt) : cB;
        for (int t = 0; t < nt; t += 2) {
            const bool last = (t == nt - 2);
            const char* a1 = cA + (size_t)(t + 1) * kstep;
            const char* a2 = last ? nA : cA + (size_t)(t + 2) * kstep; const char* b2 = last ? nB : cB + (size_t)(t + 2) * kstep;
            const char* a3 = a2 + kstep; const char* b3 = b2 + kstep;
            PG8_LDB(B0, 0, 0); PG8_LDB(B1, 0, 1); PG8_SCHED; PG8_LDA(At, 0, 0); PG8_STAGE(PG8_SA(1, 1), a1 + hstep, voffA);
            PG8_WAIT_V(8); PG8_WAIT_L(0); PG8_BAR; PG8_MMA(0, 0, At, B0); PG8_MMA(0, 1, At, B1); PG8_BAR; PG8_SCHED;
            PG8_LDA(At, 0, 1); PG8_STAGE(PG8_SB(0, 0), b2, voffB); PG8_STAGE(PG8_SB(0, 1), b2 + hstep, voffB); PG8_STAGE(PG8_SA(0, 0), a2, voffA);
            PG8_WAIT_V(8); PG8_WAIT_L(0); PG8_BAR; PG8_MMA(1, 0, At, B0); PG8_MMA(1, 1, At, B1); PG8_BAR; PG8_SCHED;
            PG8_LDB(B0, 1, 0); PG8_LDB(B1, 1, 1); PG8_SCHED; PG8_LDA(At, 1, 0); PG8_STAGE(PG8_SA(0, 1), a2 + hstep, voffA);
            PG8_WAIT_V(8); PG8_WAIT_L(0); PG8_BAR; PG8_MMA(0, 0, At, B0); PG8_MMA(0, 1, At, B1); PG8_BAR; PG8_SCHED;
            PG8_LDA(At, 1, 1); PG8_STAGE(PG8_SB(1, 0), b3, voffB); PG8_STAGE(PG8_SB(1, 1), b3 + hstep, voffB); PG8_STAGE(PG8_SA(1, 0), a3, voffA);
            PG8_WAIT_V(8); PG8_WAIT_L(0); PG8_BAR; PG8_MMA(1, 0, At, B0); PG8_MMA(1, 1, At, B1); PG8_BAR; PG8_SCHED;
        }
        if (wr == 0) PG8_BAR;
        E(acc, cur, wr, wc, fr, fq);
        if (!has_next) break;
        if (!(Epi::KEEPS && E.keep(cur))) {
#pragma unroll
        for (int a = 0; a < 2; ++a)
#pragma unroll
            for (int b = 0; b < 2; ++b)
#pragma unroll
                for (int m = 0; m < 4; ++m)
#pragma unroll
                    for (int n = 0; n < 2; ++n) acc[a][b][m][n] = (f32x4){0.f, 0.f, 0.f, 0.f};
        }
        cur = nxt; cA = nA; cB = nB; ++ui;
        if (wr == 1) PG8_BAR;
    }
    PG8_WAIT_V(0);
    PG8_BAR;
#undef PG8_SA
#undef PG8_SB
#undef PG8_STAGE
#undef PG8_LDA
#undef PG8_LDB
#undef PG8_MMA
#undef PG8_WAIT_V
#undef PG8_WAIT_L
#undef PG8_BAR
#undef PG8_SCHED
}

struct EpiA {
    static constexpr bool KEEPS = false;
    __device__ __forceinline__ bool keep(const Unit&) const { return false; }
    bf16_t* P1; bf16_t* G; const float* rss; const float* lbs_l;
    __device__ __forceinline__ void operator()(f32x4 (&acc)[2][2][4][2], const Unit& u, int wr, int wc, int fr, int fq) const {
        const int fn = u.pn >> 1;
        const int act = (fn == 0) ? 1 : ((fn == 3 || fn >= 9) ? 2 : ((fn == 7 || fn == 8) ? 3 : ((fn == 1) ? 4 : 0)));
        bf16_t* base; int ldc, colt;
        if (u.pn < 18) { base = P1; ldc = NP1; colt = u.pn * BM; } else { base = G; ldc = NG; colt = u.pn * BM - NP1; }
        const int row0 = u.pm * BM + wr * 64 + fr, col0 = colt + wc * 32 + 8 * fq;
        float lbv[2][8];
#pragma unroll
        for (int bj = 0; bj < 2; ++bj)
#pragma unroll
            for (int j = 0; j < 8; ++j) lbv[bj][j] = 0.f;
        if (act == 4) {
#pragma unroll
            for (int bj = 0; bj < 2; ++bj) { const f32x4 a = *(const f32x4*)(lbs_l + col0 - BW + bj * HALF), b = *(const f32x4*)(lbs_l + col0 - BW + bj * HALF + 4);
                lbv[bj][0] = a.x; lbv[bj][1] = a.y; lbv[bj][2] = a.z; lbv[bj][3] = a.w; lbv[bj][4] = b.x; lbv[bj][5] = b.y; lbv[bj][6] = b.z; lbv[bj][7] = b.w; } }
#pragma unroll
        for (int ai = 0; ai < 2; ++ai)
#pragma unroll
            for (int m = 0; m < 4; ++m) { const int row = row0 + ai * HALF + m * 16; const float rs = row_rs4(rss, row, fq);
                bf16_t* rowp = base + (size_t)row * ldc + col0;
#pragma unroll
                for (int bj = 0; bj < 2; ++bj) { float v[8];
#pragma unroll
                    for (int j = 0; j < 4; ++j) { v[j] = acc[ai][bj][m][0][j] * rs; v[4 + j] = acc[ai][bj][m][1][j] * rs; }
                    if (act == 2) {
#pragma unroll
                        for (int j = 0; j < 8; ++j) v[j] = __builtin_amdgcn_rcpf(1.0f + __builtin_amdgcn_exp2f(v[j] * -1.4426950409f));
                    } else if (act == 1) {
#pragma unroll
                        for (int j = 0; j < 8; ++j) v[j] = v[j] * __builtin_amdgcn_rcpf(1.0f + __builtin_amdgcn_exp2f(v[j] * -1.4426950409f));
                    } else if (act == 3) {
#pragma unroll
                        for (int j = 0; j < 8; ++j) { const float x = v[j], y = x * (-2.3022082f + -0.1029432f * x * x); v[j] = x * __builtin_amdgcn_rcpf(1.0f + __builtin_amdgcn_exp2f(y)); }
                    } else if (act == 4) {
#pragma unroll
                        for (int j = 0; j < 8; ++j) { const float x = fminf(fmaxf(v[j], -30.f), 30.f), s = __builtin_amdgcn_rcpf(1.0f + __builtin_amdgcn_exp2f(x * -1.4426950409f)); v[j] = lbv[bj][j] + (1.0f - lbv[bj][j]) * s; }
                    }
                    u32x4 w; w.x = cvt_pk_h(v[0], v[1]); w.y = cvt_pk_h(v[2], v[3]); w.z = cvt_pk_h(v[4], v[5]); w.w = cvt_pk_h(v[6], v[7]);
                    *(u32x4*)(rowp + bj * HALF) = w; } }
    }
};
struct EpiC {
    const bf16_t* G; bf16_t* MB;
    static constexpr bool KEEPS = true;
    __device__ __forceinline__ bool keep(const Unit& u) const { return u.br != 2; }
    __device__ __forceinline__ void operator()(f32x4 (&acc)[2][2][4][2], const Unit& u, int wr, int wc, int fr, int fq) const {
        const int row0 = u.pm * BM + wr * 64 + fr, col0 = u.pn * BM + wc * 32 + 8 * fq; const int br = u.br;
#pragma unroll
        for (int ai = 0; ai < 2; ++ai)
#pragma unroll
            for (int m = 0; m < 4; ++m) { const int row = row0 + ai * HALF + m * 16;
#pragma unroll
                for (int bj = 0; bj < 2; ++bj) { const int col = col0 + bj * HALF;
                    const u32x4 g = *(const u32x4*)(G + (size_t)row * NG + br * D + col);
                    f32x4 s0 = (f32x4){h_lo(g.x), h_hi(g.x), h_lo(g.y), h_hi(g.y)}, s1 = (f32x4){h_lo(g.z), h_hi(g.z), h_lo(g.w), h_hi(g.w)};
#pragma unroll
                    for (int j = 0; j < 4; ++j) { s0[j] = fmaxf(s0[j], 5.9604645e-8f); s1[j] = fmaxf(s1[j], 5.9604645e-8f); }
                    if (br != 2) { const u32x4 gn = *(const u32x4*)(G + (size_t)row * NG + (br + 1) * D + col);
                        const f32x4 d0 = (f32x4){h_lo(gn.x), h_hi(gn.x), h_lo(gn.y), h_hi(gn.y)}, d1 = (f32x4){h_lo(gn.z), h_hi(gn.z), h_lo(gn.w), h_hi(gn.w)};
#pragma unroll
                        for (int j = 0; j < 4; ++j) { s0[j] *= __builtin_amdgcn_rcpf(fmaxf(d0[j], 5.9604645e-8f)); s1[j] *= __builtin_amdgcn_rcpf(fmaxf(d1[j], 5.9604645e-8f)); }
                        acc[ai][bj][m][0] *= s0; acc[ai][bj][m][1] *= s1;
                    } else { const f32x4 v0 = acc[ai][bj][m][0] * s0, v1 = acc[ai][bj][m][1] * s1;
                        u32x4 w; w.x = cvt_pk_h(v0[0], v0[1]); w.y = cvt_pk_h(v0[2], v0[3]); w.z = cvt_pk_h(v1[0], v1[1]); w.w = cvt_pk_h(v1[2], v1[3]);
                        *(u32x4*)(MB + (size_t)row * D + col) = w; } } }
    }
};
struct EpiRes {
    static constexpr bool KEEPS = false;
    __device__ __forceinline__ bool keep(const Unit&) const { return false; }
    const float* Xin; float* X; bf16_t* XB; float* rss; int dummy;
    __device__ __forceinline__ void operator()(f32x4 (&acc)[2][2][4][2], const Unit& u, int wr, int wc, int fr, int fq) const {
        const int row0 = u.pm * BM + wr * 64 + fr, col0 = u.pn * BM + wc * 32 + 8 * fq;
#pragma unroll
        for (int ai = 0; ai < 2; ++ai)
#pragma unroll
            for (int m = 0; m < 4; ++m) { const int row = row0 + ai * HALF + m * 16; float ss = 0.f;
#pragma unroll
                for (int bj = 0; bj < 2; ++bj) { const int col = col0 + bj * HALF; float* xp = X + (size_t)row * D + col; const float* xi = Xin + (size_t)row * D + col;
                    const f32x4 x0 = *(const f32x4*)xi + acc[ai][bj][m][0], x1 = *(const f32x4*)(xi + 4) + acc[ai][bj][m][1];
                    if (!dummy) { *(f32x4*)xp = x0; *(f32x4*)(xp + 4) = x1; }
                    ss += (x0[0] * x0[0] + x0[1] * x0[1]) + (x0[2] * x0[2] + x0[3] * x0[3]) + (x1[0] * x1[0] + x1[1] * x1[1]) + (x1[2] * x1[2] + x1[3] * x1[3]);
                    u32x4 w; w.x = cvt_pk_h(x0[0], x0[1]); w.y = cvt_pk_h(x0[2], x0[3]); w.z = cvt_pk_h(x1[0], x1[1]); w.w = cvt_pk_h(x1[2], x1[3]);
                    if (XB != nullptr && (!dummy || ss == 12345.678f)) *(u32x4*)(XB + (size_t)row * D + col) = w; }
                ss += __shfl_xor(ss, 16); ss += __shfl_xor(ss, 32);
                if (fq == 0 && (!dummy || ss == 12345.678f)) rss[(size_t)row * 16 + u.pn * 4 + wc] = ss; }
    }
};
struct EpiE {
    static constexpr bool KEEPS = false;
    __device__ __forceinline__ bool keep(const Unit&) const { return false; }
    bf16_t* H; const float* rss;
    __device__ __forceinline__ void operator()(f32x4 (&acc)[2][2][4][2], const Unit& u, int wr, int wc, int fr, int fq) const {
        const int row0 = u.pm * BM + wr * 64 + fr, col0 = u.pn * BM + wc * 32 + 8 * fq;
#pragma unroll
        for (int ai = 0; ai < 2; ++ai)
#pragma unroll
            for (int m = 0; m < 4; ++m) { const int row = row0 + ai * HALF + m * 16; const float rs = row_rs4(rss, row, fq);
#pragma unroll
                for (int bj = 0; bj < 2; ++bj) { float v[8];
#pragma unroll
                    for (int j = 0; j < 4; ++j) { const float a = fmaxf(acc[ai][bj][m][0][j] * rs, 0.f), b = fmaxf(acc[ai][bj][m][1][j] * rs, 0.f); v[j] = a * a; v[4 + j] = b * b; }
                    u32x4 w; w.x = cvt_pk_h(v[0], v[1]); w.y = cvt_pk_h(v[2], v[3]); w.z = cvt_pk_h(v[4], v[5]); w.w = cvt_pk_h(v[6], v[7]);
                    *(u32x4*)(H + (size_t)row * FF + col0 + bj * HALF) = w; } }
    }
};
}

struct TDesc { const float* W; const float* gs; bf16_t* WT; int K, N, item; };
__device__ __forceinline__ void titem_load(const TDesc& d, f32x4 (&v)[16], int lane) {
    const int nblk = d.N / 64, kb = d.item / nblk, nb = d.item - kb * nblk, k0 = 64 * kb, n0 = 64 * nb;
    const int lr = lane >> 4, lc = (lane & 15) * 4;
#pragma unroll
    for (int i = 0; i < 16; ++i) v[i] = *(const f32x4*)(d.W + (size_t)(k0 + 4 * i + lr) * d.N + n0 + lc);
}
__device__ __forceinline__ void titem_finish(const TDesc& d, const f32x4 (&v)[16], LAS float* scr, int lane) {
    const int nblk = d.N / 64, kb = d.item / nblk, nb = d.item - kb * nblk, k0 = 64 * kb, n0 = 64 * nb;
    const int lr = lane >> 4, lc = (lane & 15) * 4;
#pragma unroll
    for (int i = 0; i < 16; ++i) { LAS float* p = scr + (4 * i + lr) * 65 + lc; p[0] = v[i].x; p[1] = v[i].y; p[2] = v[i].z; p[3] = v[i].w; }
    asm volatile("s_waitcnt lgkmcnt(0)" ::: "memory");
    const int c = lane & 7;
    f32x4 g0 = (f32x4){1.f, 1.f, 1.f, 1.f}, g1 = g0;
    if (d.gs) { g0 = *(const f32x4*)(d.gs + k0 + 8 * c); g1 = *(const f32x4*)(d.gs + k0 + 8 * c + 4); }
#pragma unroll
    for (int j = 0; j < 8; ++j) { const int n = (lane >> 3) + 8 * j; const LAS float* s = scr + (8 * c) * 65 + n;
        u32x4 o; o.x = cvt_pk_h(s[0 * 65] * g0.x, s[1 * 65] * g0.y); o.y = cvt_pk_h(s[2 * 65] * g0.z, s[3 * 65] * g0.w); o.z = cvt_pk_h(s[4 * 65] * g1.x, s[5 * 65] * g1.y); o.w = cvt_pk_h(s[6 * 65] * g1.z, s[7 * 65] * g1.w);
        *(u32x4*)(d.WT + (size_t)(n0 + n) * d.K + k0 + 8 * c) = o; }
    asm volatile("s_waitcnt lgkmcnt(0)" ::: "memory");
}
struct Args {
    const float* x; const float* w_in; const float* g_mix; const float* lower_bounds; const float* g_hgrn_out; const float* w_conv;
    const float* sg_ln_g; const float* sg_ln_b; const float* w_sg; const float* b_sg; const float* w_branch; const float* w_o;
    const float* g_ffn; const float* w_ff1; const float* w_ff2; const float* g_final;
    float* out; unsigned char* ws; int ph_lo, ph_hi;
};

__device__ __forceinline__ TDesc layer_item(const Args& a, unsigned char* ws, int l, int r) {
    constexpr int I_IN = (D / 64) * (NIN / 64), I_BR = (BW / 64) * (D / 64), I_O = (D / 64) * (D / 64), I_1 = (D / 64) * (FF / 64);
    TDesc d;
    if (r < I_IN) { d.W = a.w_in + (size_t)l * D * NIN; d.gs = a.g_mix + l * D; d.WT = (bf16_t*)(ws + WS_WIN) + (size_t)l * NIN * D; d.K = D; d.N = NIN; d.item = r; return d; } r -= I_IN;
    if (r < 3 * I_BR) { const int br = r / I_BR; d.W = a.w_branch + (size_t)(l * 3 + br) * BW * D; d.gs = nullptr; d.WT = (bf16_t*)(ws + WS_WBR) + (size_t)(l * 3 + br) * D * BW; d.K = BW; d.N = D; d.item = r - br * I_BR; return d; } r -= 3 * I_BR;
    if (r < I_O) { d.W = a.w_o + (size_t)l * D * D; d.gs = nullptr; d.WT = (bf16_t*)(ws + WS_WO) + (size_t)l * D * D; d.K = D; d.N = D; d.item = r; return d; } r -= I_O;
    if (r < I_1) { d.W = a.w_ff1 + (size_t)l * D * FF; d.gs = a.g_ffn + l * D; d.WT = (bf16_t*)(ws + WS_W1) + (size_t)l * FF * D; d.K = D; d.N = FF; d.item = r; return d; } r -= I_1;
    d.W = a.w_ff2 + (size_t)l * FF * D; d.gs = nullptr; d.WT = (bf16_t*)(ws + WS_W2) + (size_t)l * D * FF; d.K = FF; d.N = D; d.item = r; return d;
}
__device__ __forceinline__ void convert_layer(const Args& a, unsigned char* ws, int l, int worker, int nworkers, LAS float* scr, int lane) {
    constexpr int NITEMS = (D / 64) * (NIN / 64) + 3 * (BW / 64) * (D / 64) + (D / 64) * (D / 64) + (D / 64) * (FF / 64) + (FF / 64) * (D / 64);
    int it = worker; if (it >= NITEMS) return;
    TDesc dc = layer_item(a, ws, l, it); f32x4 vc[16]; titem_load(dc, vc, lane);
    for (;;) { const int nx = it + nworkers; const bool has = nx < NITEMS;
        TDesc dn = dc; f32x4 vn[16];
#pragma unroll
        for (int i = 0; i < 16; ++i) vn[i] = vc[i];
        if (has) { dn = layer_item(a, ws, l, nx); titem_load(dn, vn, lane); }
        titem_finish(dc, vc, scr, lane);
        if (!has) break;
        dc = dn; it = nx;
#pragma unroll
        for (int i = 0; i < 16; ++i) vc[i] = vn[i]; }
}

__device__ __forceinline__ void prologue(const Args& a, LAS unsigned char* lds, int wave, int lane, int vcu, int G) {
    unsigned char* ws = a.ws;
    LAS float* scr = (LAS float*)(lds + wave * 16640);
    const int gw = vcu * 8 + wave, NGW = G * 8;
    convert_layer(a, ws, 0, gw, NGW, scr, lane);
    bf16_t* XB = (bf16_t*)(ws + WS_XB); float* rss = (float*)(ws + WS_RSS);
    for (int m = gw; m < T; m += NGW) {
        const f32x4* xr = (const f32x4*)(a.x + (size_t)m * D) + lane; u32x2* bo = (u32x2*)(XB + (size_t)m * D) + lane;
        float s = 0.f;
#pragma unroll
        for (int j = 0; j < 4; ++j) { const f32x4 v = xr[64 * j]; s += (v.x * v.x + v.y * v.y) + (v.z * v.z + v.w * v.w);
            u32x2 w; w.x = cvt_pk_h(v.x, v.y); w.y = cvt_pk_h(v.z, v.w); bo[64 * j] = w; }
        s = wave_sum(s);
        if (lane < 16) rss[(size_t)m * 16 + lane] = (lane == 0) ? s : 0.f;
    }
    if (vcu == 0) { const int w = wave * 64 + lane; float* lbs = (float*)(ws + WS_LBS);
        float v[DEPTH]; float mx = -1e30f;
#pragma unroll
        for (int i = 0; i < DEPTH; ++i) { v[i] = a.lower_bounds[i * BW + w]; mx = fmaxf(mx, v[i]); }
        float sum = 0.f;
#pragma unroll
        for (int i = 0; i < DEPTH; ++i) { v[i] = __expf(v[i] - mx); sum += v[i]; }
        float cum = 0.f; const float inv = 1.0f / sum;
#pragma unroll
        for (int i = 0; i < DEPTH; ++i) { if (i > 0) cum += v[i] * inv; lbs[i * BW + w] = cum; }
    }
}

__device__ __forceinline__ void unpack8(const u32x4 w, float (&f)[8]) { f[0] = h_lo(w.x); f[1] = h_hi(w.x); f[2] = h_lo(w.y); f[3] = h_hi(w.y); f[4] = h_lo(w.z); f[5] = h_hi(w.z); f[6] = h_lo(w.w); f[7] = h_hi(w.w); }
__device__ __forceinline__ u32x4 pack8(const float (&f)[8]) { u32x4 w; w.x = cvt_pk_h(f[0], f[1]); w.y = cvt_pk_h(f[2], f[3]); w.z = cvt_pk_h(f[4], f[5]); w.w = cvt_pk_h(f[6], f[7]); return w; }
__device__ __forceinline__ u32x4 pack8_truebf16(const float (&f)[8]) { u32x4 w; w.x = cvt_pk_truebf16(f[0], f[1]); w.y = cvt_pk_truebf16(f[2], f[3]); w.z = cvt_pk_truebf16(f[4], f[5]); w.w = cvt_pk_truebf16(f[6], f[7]); return w; }
__device__ __forceinline__ unsigned short bf16_of(float f) { return (unsigned short)(cvt_pk_h(f, 0.f) & 0xffffu); }

constexpr int HL_BL = 0;
constexpr int HL_SEG = 32768;
constexpr int HL_A1 = 34816;
constexpr int HL_BK = HL_A1 + 17408;
constexpr int HL_QH = HL_BK + 17408;
constexpr int HL_VT = HL_QH + 17408;
constexpr int HL_P = HL_VT + 18432;
constexpr int HL_RS = HL_P + 9216;
constexpr int HL_KT = HL_A1;
static_assert(HL_RS + 512 <= LDS_BYTES, "hgrn lds");

struct HPre { u32x4 f[2], iv[2]; };
template <bool WANT_Q> __device__ __forceinline__ void hgrn_load(HPre& p, const bf16_t* P1, int unit, int tid) {
    const int bh = unit >> 5, c = unit & 31, t0 = (bh >> 2) * SEQ + c * 64, ch0 = (bh & 3) * 128, c8 = tid & 15;
#pragma unroll
    for (int j = 0; j < 2; ++j) { const bf16_t* rp = P1 + (size_t)(t0 + (tid >> 4) + 32 * j) * NP1 + ch0 + 8 * c8;
        p.f[j] = *(const u32x4*)(rp + BW); p.iv[j] = *(const u32x4*)(rp + 2 * BW); }
}
__device__ __forceinline__ void hgrn_prep(const HPre& pre, LAS unsigned char* lds, int tid, float (&kk)[2][8]) {
    LAS float* BL = (LAS float*)(lds + HL_BL); LAS float* SEG = (LAS float*)(lds + HL_SEG);
    const int c8 = tid & 15;
#pragma unroll
    for (int j = 0; j < 2; ++j) { const int r = (tid >> 4) + 32 * j;
        float f[8]; unpack8(pre.f[j], f);
        float lf[8];
#pragma unroll
        for (int e = 0; e < 8; ++e) { lf[e] = __logf(fmaxf(f[e], 5.9604645e-8f)); kk[j][e] = 1.0f - f[e]; }
        *(LAS f32x4*)(BL + r * 128 + 8 * c8) = (f32x4){lf[0], lf[1], lf[2], lf[3]}; *(LAS f32x4*)(BL + r * 128 + 8 * c8 + 4) = (f32x4){lf[4], lf[5], lf[6], lf[7]}; }
    __syncthreads();
    { const int ch = tid & 127, seg = tid >> 7; float v[16]; float run = 0.f;
#pragma unroll
      for (int j = 0; j < 16; ++j) { run += BL[(seg * 16 + j) * 128 + ch]; v[j] = run; }
      SEG[seg * 128 + ch] = run;
      __syncthreads();
      float pre = 0.f;
#pragma unroll
      for (int s = 0; s < 3; ++s) { const float tot = SEG[s * 128 + ch]; if (s < seg) pre += tot; }
#pragma unroll
      for (int j = 0; j < 16; ++j) BL[(seg * 16 + j) * 128 + ch] = v[j] + pre; }
    __syncthreads();
}

__device__ __forceinline__ void hgrn_pass1(const bf16_t* P1, HPre& pre, int next_unit, bf16_t* ST, float* DEC, LAS unsigned char* lds, int unit, int tid, int wave, int lane) {
    const int bh = unit >> 5, c = unit & 31, b = bh >> 2, h = bh & 3, t0 = b * SEQ + c * 64, ch0 = h * 128;
    float kk[2][8];
    __syncthreads();
    hgrn_prep(pre, lds, tid, kk);
    LAS float* BL = (LAS float*)(lds + HL_BL);
    LAS unsigned short* KT = (LAS unsigned short*)(lds + HL_KT); LAS unsigned short* VT = (LAS unsigned short*)(lds + HL_VT);
    const int c8 = tid & 15;
    float bl[8];
    { const f32x4 a = *(const LAS f32x4*)(BL + 63 * 128 + 8 * c8), bq = *(const LAS f32x4*)(BL + 63 * 128 + 8 * c8 + 4); bl[0] = a.x; bl[1] = a.y; bl[2] = a.z; bl[3] = a.w; bl[4] = bq.x; bl[5] = bq.y; bl[6] = bq.z; bl[7] = bq.w; }
#pragma unroll
    for (int j = 0; j < 2; ++j) { const int r = (tid >> 4) + 32 * j;
        const f32x4 b0 = *(const LAS f32x4*)(BL + r * 128 + 8 * c8), b1 = *(const LAS f32x4*)(BL + r * 128 + 8 * c8 + 4);
        const float B[8] = {b0.x, b0.y, b0.z, b0.w, b1.x, b1.y, b1.z, b1.w};
        float iv[8]; unpack8(pre.iv[j], iv);
#pragma unroll
        for (int e = 0; e < 8; ++e) { KT[(8 * c8 + e) * 72 + (r ^ ((c8 & 7) << 3))] = bf16_of(kk[j][e] * __expf(bl[e] - B[e])); VT[(8 * c8 + e) * 72 + (r ^ ((c8 & 7) << 3))] = bf16_of(iv[e]); } }
    if (tid < 128) DEC[(size_t)unit * 128 + tid] = __expf(BL[63 * 128 + tid]);
    if (next_unit < 1024) hgrn_load<false>(pre, P1, next_unit, tid);
    __syncthreads();
    const int l16 = lane & 15, lq = lane >> 4;
    bf16x8 af[2];
#pragma unroll
    for (int ks = 0; ks < 2; ++ks) af[ks] = *(const LAS bf16x8*)(lds + HL_KT + (wave * 16 + l16) * 144 + (((ks * 4 + lq) ^ ((2 * wave + (l16 >> 3)) & 7)) << 4));
#pragma unroll
    for (int vt = 0; vt < 8; ++vt) { f32x4 acc = (f32x4){0.f, 0.f, 0.f, 0.f};
#pragma unroll
        for (int ks = 0; ks < 2; ++ks) { const bf16x8 bfr = *(const LAS bf16x8*)(lds + HL_VT + (vt * 16 + l16) * 144 + (((ks * 4 + lq) ^ ((2 * vt + (l16 >> 3)) & 7)) << 4));
            acc = MFMA_H(af[ks], bfr, acc); }
        u32x2 w; w.x = cvt_pk_h(acc[0], acc[1]); w.y = cvt_pk_h(acc[2], acc[3]);
        *(u32x2*)(ST + ((size_t)unit * 128 + vt * 16 + l16) * 128 + wave * 16 + 4 * lq) = w; }
}

__device__ __forceinline__ void hgrn_pass3(const bf16_t* P1, HPre& pre, int next_unit, const bf16_t* ST, const float* gout_l, bf16_t* ZA, LAS unsigned char* lds, int unit, int tid, int wave, int lane) {
    const int bh = unit >> 5, c = unit & 31, b = bh >> 2, h = bh & 3, t0 = b * SEQ + c * 64, ch0 = h * 128;
    float kk[2][8];
    __syncthreads();
    hgrn_prep(pre, lds, tid, kk);
    LAS float* BL = (LAS float*)(lds + HL_BL);
    LAS unsigned short* VT = (LAS unsigned short*)(lds + HL_VT);
    const int c8 = tid & 15;
    float rf[8];
    { const f32x4 a = *(const LAS f32x4*)(BL + 31 * 128 + 8 * c8), bq = *(const LAS f32x4*)(BL + 31 * 128 + 8 * c8 + 4); rf[0] = a.x; rf[1] = a.y; rf[2] = a.z; rf[3] = a.w; rf[4] = bq.x; rf[5] = bq.y; rf[6] = bq.z; rf[7] = bq.w; }
#pragma unroll
    for (int j = 0; j < 2; ++j) { const int r = (tid >> 4) + 32 * j;
        const f32x4 b0 = *(const LAS f32x4*)(BL + r * 128 + 8 * c8), b1 = *(const LAS f32x4*)(BL + r * 128 + 8 * c8 + 4);
        const float B[8] = {b0.x, b0.y, b0.z, b0.w, b1.x, b1.y, b1.z, b1.w};
        float q[8]; unpack8(*(const u32x4*)(P1 + (size_t)(t0 + r) * NP1 + ch0 + 8 * c8), q);
        float iv[8]; unpack8(pre.iv[j], iv);
        float a1[8], bk[8], qh[8];
#pragma unroll
        for (int e = 0; e < 8; ++e) { const float d = B[e] - rf[e]; a1[e] = q[e] * __expf(fminf(d, 80.f)); bk[e] = kk[j][e] * __expf(fminf(-d, 80.f)); qh[e] = q[e] * __expf(B[e]); VT[(8 * c8 + e) * 72 + (r ^ ((c8 & 7) << 3))] = bf16_of(iv[e]); }
        *(LAS u32x4*)(lds + HL_A1 + r * 272 + 16 * c8) = pack8_truebf16(a1);
        *(LAS u32x4*)(lds + HL_BK + r * 272 + 16 * c8) = pack8_truebf16(bk);
        *(LAS u32x4*)(lds + HL_QH + r * 272 + 16 * c8) = pack8(qh); }
    if (next_unit < 1024) hgrn_load<true>(pre, P1, next_unit, tid);
    const int l16 = lane & 15, lq = lane >> 4;
    bf16x8 sf[4][4]; u32x2 gov[4];
    { const int vh_ = wave >> 2, ti_ = wave & 3;
#pragma unroll
      for (int jv = 0; jv < 4; ++jv) { const bf16_t* sp = ST + ((size_t)unit * 128 + (vh_ * 4 + jv) * 16 + l16) * 128 + 8 * lq;
#pragma unroll
          for (int k4 = 0; k4 < 4; ++k4) sf[jv][k4] = *(const bf16x8*)(sp + k4 * 32);
          gov[jv] = *(const u32x2*)(P1 + (size_t)(t0 + ti_ * 16 + l16) * NP1 + 3 * BW + ch0 + (vh_ * 4 + jv) * 16 + 4 * lq); } }
    __syncthreads();
#pragma unroll
    for (int j = 0; j < 2; ++j) { const int id = 2 * wave + j, si = id >> 2, ti = id & 3; f32x4 acc = (f32x4){0.f, 0.f, 0.f, 0.f};
#pragma unroll
        for (int k4 = 0; k4 < 4; ++k4) { const bf16x8 af = *(const LAS bf16x8*)(lds + HL_BK + (si * 16 + l16) * 272 + (k4 * 32 + 8 * lq) * 2);
            const bf16x8 bfr = *(const LAS bf16x8*)(lds + HL_A1 + (ti * 16 + l16) * 272 + (k4 * 32 + 8 * lq) * 2);
            acc = __builtin_amdgcn_mfma_f32_16x16x32_bf16(af, bfr, acc, 0, 0, 0); }
#pragma unroll
        for (int r = 0; r < 4; ++r) { const bool keep = (si < ti) || (si == ti && 4 * lq + r <= l16); acc[r] = keep ? acc[r] : 0.f; }
        u32x2 w; w.x = cvt_pk_h(acc[0], acc[1]); w.y = cvt_pk_h(acc[2], acc[3]);
        *(LAS u32x2*)(lds + HL_P + (ti * 16 + l16) * 144 + (si * 16 + 4 * lq) * 2) = w; }
    __syncthreads();
    const int ti = wave & 3, vh = wave >> 2;
    f32x4 o[4]; float ss = 0.f;
    bf16x8 pf[2], qf[4];
#pragma unroll
    for (int ks = 0; ks < 2; ++ks) pf[ks] = *(const LAS bf16x8*)(lds + HL_P + (ti * 16 + l16) * 144 + (ks * 32 + 8 * lq) * 2);
#pragma unroll
    for (int k4 = 0; k4 < 4; ++k4) qf[k4] = *(const LAS bf16x8*)(lds + HL_QH + (ti * 16 + l16) * 272 + (k4 * 32 + 8 * lq) * 2);
#pragma unroll
    for (int jv = 0; jv < 4; ++jv) { const int vt = vh * 4 + jv; f32x4 acc = (f32x4){0.f, 0.f, 0.f, 0.f};
#pragma unroll
        for (int ks = 0; ks < 2; ++ks) { const bf16x8 af = *(const LAS bf16x8*)(lds + HL_VT + (vt * 16 + l16) * 144 + (((ks * 4 + lq) ^ ((2 * vt + (l16 >> 3)) & 7)) << 4));
            acc = MFMA_H(af, pf[ks], acc); }
#pragma unroll
        for (int k4 = 0; k4 < 4; ++k4) acc = MFMA_H(sf[jv][k4], qf[k4], acc);
        o[jv] = acc; ss += (acc[0] * acc[0] + acc[1] * acc[1]) + (acc[2] * acc[2] + acc[3] * acc[3]); }
    ss += __shfl_xor(ss, 16); ss += __shfl_xor(ss, 32);
    LAS float* RS = (LAS float*)(lds + HL_RS);
    if (lq == 0) RS[vh * 64 + ti * 16 + l16] = ss;
    __syncthreads();
    const float rstd = rsqrtf((RS[ti * 16 + l16] + RS[64 + ti * 16 + l16]) * (1.0f / 128.0f) + NORM_EPS);
    const int trow = t0 + ti * 16 + l16;
#pragma unroll
    for (int jv = 0; jv < 4; ++jv) { const int v = (vh * 4 + jv) * 16 + 4 * lq;
        const f32x4 g4 = *(const f32x4*)(gout_l + ch0 + v);
        const u32x2 go = gov[jv];
        const f32x4 r = o[jv] * rstd * g4 * (f32x4){h_lo(go.x), h_hi(go.x), h_lo(go.y), h_hi(go.y)};
        u32x2 w; w.x = cvt_pk_h(r[0], r[1]); w.y = cvt_pk_h(r[2], r[3]);
        *(u32x2*)(ZA + (size_t)trow * BW + ch0 + v) = w; }
}

__device__ __forceinline__ void hgrn_scan(const bf16_t* SL, bf16_t* ST, const float* DEC, int gtid, int nthreads) {
    for (int it = gtid; it < 32 * 128 * 32; it += nthreads) {
        const int bh = it >> 12, rem = it & 4095, v = rem >> 5, k4 = (rem & 31) * 4;
        const bf16_t* lp = SL + ((size_t)(bh * 32) * 128 + v) * 128 + k4; bf16_t* sp = ST + ((size_t)(bh * 32) * 128 + v) * 128 + k4; const float* dp = DEC + (size_t)(bh * 32) * 128 + k4;
        u32x2 Lv[32];
#pragma unroll
        for (int c = 0; c < 32; ++c) Lv[c] = *(const u32x2*)(lp + (size_t)c * 128 * 128);
        f32x4 S = (f32x4){0.f, 0.f, 0.f, 0.f};
#pragma unroll
        for (int c0 = 0; c0 < 32; c0 += 8) { f32x4 dv[8];
#pragma unroll
            for (int j = 0; j < 8; ++j) dv[j] = *(const f32x4*)(dp + (size_t)(c0 + j) * 128);
#pragma unroll
            for (int j = 0; j < 8; ++j) { u32x2 w; w.x = cvt_pk_h(S[0], S[1]); w.y = cvt_pk_h(S[2], S[3]);
                *(u32x2*)(sp + (size_t)(c0 + j) * 128 * 128) = w;
                S = dv[j] * S + (f32x4){h_lo(Lv[c0 + j].x), h_hi(Lv[c0 + j].x), h_lo(Lv[c0 + j].y), h_hi(Lv[c0 + j].y)}; } }
    }
}

__device__ __forceinline__ void conv_phase(const bf16_t* P1, const float* wconv_l, bf16_t* ZB, int gtid, int nthreads) {
    for (int it = gtid; it < (T / 4) * 64; it += nthreads) {
        const int c8 = it & 63, t = (it >> 6) * 4; const bool head = ((t & (SEQ - 1)) == 0);
        u32x4 cgr[6], xcr[6], bgr[4];
#pragma unroll
        for (int i = 0; i < 6; ++i) { const int row = (i < 2 && head) ? t : (t - 2 + i); const bf16_t* rp = P1 + (size_t)row * NP1 + 8 * c8; cgr[i] = *(const u32x4*)(rp + 5 * BW); xcr[i] = *(const u32x4*)(rp + 6 * BW); }
#pragma unroll
        for (int o = 0; o < 4; ++o) bgr[o] = *(const u32x4*)(P1 + (size_t)(t + o) * NP1 + 4 * BW + 8 * c8);
        float wc[3][8];
#pragma unroll
        for (int j = 0; j < 3; ++j) { const f32x4 a = *(const f32x4*)(wconv_l + j * BW + 8 * c8), bq = *(const f32x4*)(wconv_l + j * BW + 8 * c8 + 4);
            wc[j][0] = a.x; wc[j][1] = a.y; wc[j][2] = a.z; wc[j][3] = a.w; wc[j][4] = bq.x; wc[j][5] = bq.y; wc[j][6] = bq.z; wc[j][7] = bq.w; }
        float z[6][8];
#pragma unroll
        for (int i = 0; i < 6; ++i) { float cgv[8], xcv[8]; unpack8(cgr[i], cgv); unpack8(xcr[i], xcv); const bool zero = (i < 2 && head);
#pragma unroll
            for (int e = 0; e < 8; ++e) z[i][e] = zero ? 0.f : cgv[e] * xcv[e]; }
#pragma unroll
        for (int o = 0; o < 4; ++o) { float bg[8]; unpack8(bgr[o], bg); float y[8];
#pragma unroll
            for (int e = 0; e < 8; ++e) y[e] = bg[e] * (wc[0][e] * z[o][e] + wc[1][e] * z[o + 1][e] + wc[2][e] * z[o + 2][e]);
            *(u32x4*)(ZB + (size_t)(t + o) * BW + 8 * c8) = pack8(y); }
    }
}

constexpr int SG_VT = 0;
__device__ __forceinline__ void sg_unit(const bf16_t* P1, const float* lng, const float* lnb, const float* wsg_l, const float* bsg_l, bf16_t* ZC, LAS unsigned char* lds, int unit, int wave, int lane) {
    const int ci = unit >> 2, g = unit & 3, t0 = ci * 128;
    LAS unsigned short* VT = (LAS unsigned short*)(lds + SG_VT);
    __syncthreads();
    const bool mine = ((lane >> 4) == g); const int d0 = (lane & 15) * 8;
    float lg[8], lb[8];
    { const f32x4 a = *(const f32x4*)(lng + g * 128 + d0), bq = *(const f32x4*)(lng + g * 128 + d0 + 4), cq = *(const f32x4*)(lnb + g * 128 + d0), dq = *(const f32x4*)(lnb + g * 128 + d0 + 4);
      lg[0] = a.x; lg[1] = a.y; lg[2] = a.z; lg[3] = a.w; lg[4] = bq.x; lg[5] = bq.y; lg[6] = bq.z; lg[7] = bq.w; lb[0] = cq.x; lb[1] = cq.y; lb[2] = cq.z; lb[3] = cq.w; lb[4] = dq.x; lb[5] = dq.y; lb[6] = dq.z; lb[7] = dq.w; }
    const int l16 = lane & 15, lq = lane >> 4, t = wave * 16 + l16, nk = (wave >> 1) + 1;
    f32x4 wraw[4][2]; u32x2 uu8[8];
    { const float* wrow = wsg_l + ((size_t)g * 128 + t) * 128 + 8 * lq;
#pragma unroll
      for (int k4 = 0; k4 < 4; ++k4) { if (k4 < nk) { wraw[k4][0] = *(const f32x4*)(wrow + k4 * 32); wraw[k4][1] = *(const f32x4*)(wrow + k4 * 32 + 4); } else { wraw[k4][0] = (f32x4){0.f, 0.f, 0.f, 0.f}; wraw[k4][1] = wraw[k4][0]; } }
#pragma unroll
      for (int jd = 0; jd < 8; ++jd) uu8[jd] = *(const u32x2*)(P1 + (size_t)(t0 + t) * NP1 + 7 * BW + g * 128 + jd * 16 + 4 * lq); }
    const float bs = bsg_l[g * 128 + t];
    u32x4 xr[16];
#pragma unroll
    for (int i = 0; i < 16; ++i) xr[i] = *(const u32x4*)(P1 + (size_t)(t0 + wave + 8 * i) * NP1 + 8 * BW + 8 * lane);
#pragma unroll
    for (int i = 0; i < 16; ++i) { const int r = wave + 8 * i;
        float x[8]; unpack8(xr[i], x);
        float s = ((x[0] + x[1]) + (x[2] + x[3])) + ((x[4] + x[5]) + (x[6] + x[7]));
        const float mean = wave_sum(s) * (1.0f / BW); float q = 0.f;
#pragma unroll
        for (int e = 0; e < 8; ++e) { x[e] -= mean; q += x[e] * x[e]; }
        const float rstd = rsqrtf(wave_sum(q) * (1.0f / BW) + LN_EPS);
        if (mine) {
#pragma unroll
            for (int e = 0; e < 8; ++e) VT[(d0 + e) * 136 + (r ^ ((lane & 15) << 3))] = bf16_of(x[e] * rstd * lg[e] + lb[e]); } }
    __syncthreads();
    bf16x8 wf[4];
#pragma unroll
    for (int k4 = 0; k4 < 4; ++k4) { float w[8] = {wraw[k4][0].x, wraw[k4][0].y, wraw[k4][0].z, wraw[k4][0].w, wraw[k4][1].x, wraw[k4][1].y, wraw[k4][1].z, wraw[k4][1].w};
#pragma unroll
        for (int e = 0; e < 8; ++e) w[e] = (k4 * 32 + 8 * lq + e <= t) ? w[e] : 0.f;
        const u32x4 pk = pack8(w); wf[k4] = __builtin_bit_cast(bf16x8, pk); }
#pragma unroll
    for (int jd = 0; jd < 8; ++jd) { f32x4 acc = (f32x4){0.f, 0.f, 0.f, 0.f};
#pragma unroll
        for (int k4 = 0; k4 < 4; ++k4) { const bf16x8 af = *(const LAS bf16x8*)(lds + SG_VT + (jd * 16 + l16) * 272 + (((k4 * 4 + lq) ^ ((2 * jd + (l16 >> 3)) & 15)) << 4));
            acc = MFMA_H(af, wf[k4], acc); }
        const int d = jd * 16 + 4 * lq;
        const u32x2 uu = uu8[jd];
        const f32x4 r = (acc + bs) * (f32x4){h_lo(uu.x), h_hi(uu.x), h_lo(uu.y), h_hi(uu.y)};
        u32x2 w; w.x = cvt_pk_h(r[0], r[1]); w.y = cvt_pk_h(r[2], r[3]);
        *(u32x2*)(ZC + (size_t)(t0 + t) * BW + g * 128 + d) = w; }
}

#define XB_TMO      128
#define XB_XCNT(j)  (256  + 64 * (j))
#define XB_XSUB(j)  (1280 + 64 * (j))
#define XB_XGEN(j)  (2304 + 64 * (j))
#define XB_TOP      3328
#define XB_TOPGEN   3392
#define XCD_BAR_WORDS 3456
#define XB_SPIN_CAP (1u << 18)

__device__ __forceinline__ unsigned xb_ld(unsigned* p)              { return __hip_atomic_load(p, __ATOMIC_RELAXED, __HIP_MEMORY_SCOPE_AGENT); }
__device__ __forceinline__ unsigned xb_add(unsigned* p, unsigned v) { return __hip_atomic_fetch_add(p, v, __ATOMIC_RELAXED, __HIP_MEMORY_SCOPE_AGENT); }
__device__ __forceinline__ unsigned xb_xcc_id() { return (unsigned)__builtin_amdgcn_s_getreg((3 << 11) | 20) & 0xFu; }
#define XB_SPIN(cond, bar) do { unsigned _sp = 0; while (cond) { __builtin_amdgcn_s_sleep(1); \
    if ((++_sp & 255u) == 0u) { if (xb_ld(&(bar)[XB_TMO])) break; if (_sp > XB_SPIN_CAP) { atomicAdd(&(bar)[XB_TMO], 1u); break; } } } } while (0)

struct XcdBarrier {
    unsigned* bar; unsigned x;
    volatile LAS unsigned* st;
};

__device__ __forceinline__ XcdBarrier xcd_barrier_post(unsigned* bar, volatile LAS unsigned* st) {
    XcdBarrier b; b.bar = bar; b.x = xb_xcc_id(); b.st = st;
    if (threadIdx.x == 0) (void)xb_add(&bar[XB_XCNT(b.x)], 1u);
    return b;
}
__device__ __forceinline__ void xcd_barrier_complete(unsigned* bar, unsigned x, unsigned& nloc, unsigned& nx) {
    const unsigned G = gridDim.x * gridDim.y * gridDim.z;
    unsigned sum, cnt, mine, sp = 0u;
    for (;;) {
        sum = 0u; cnt = 0u; mine = 0u;
#pragma unroll
        for (unsigned j = 0; j < 16; ++j) { const unsigned c = xb_ld(&bar[XB_XCNT(j)]); sum += c; cnt += (c > 0u) ? 1u : 0u; mine = (j == x) ? c : mine; }
        if (sum == G) break;
        __builtin_amdgcn_s_sleep(1);
        if ((++sp & 255u) == 0u) { if (xb_ld(&bar[XB_TMO])) break; if (sp > XB_SPIN_CAP) { atomicAdd(&bar[XB_TMO], 1u); break; } }
    }
    nloc = mine > 0u ? mine : 1u; nx = cnt > 0u ? cnt : 1u;
}

__device__ __forceinline__ void xcd_barrier(const XcdBarrier& b) {
    asm volatile("s_waitcnt vmcnt(0)" ::: "memory");
    __syncthreads();
    if (threadIdx.x == 0) {
        unsigned* bar = b.bar;
        __builtin_amdgcn_s_waitcnt(0);
        unsigned nloc = b.st[0], nx = b.st[1];
        if (nloc == 0u) { xcd_barrier_complete(bar, b.x, nloc, nx); b.st[0] = nloc; b.st[1] = nx; }
        const unsigned old = xb_add(&bar[XB_XSUB(b.x)], 1u);
        const unsigned gen = old / nloc;
        if (old + 1u == (gen + 1u) * nloc) {
            __builtin_amdgcn_fence(__ATOMIC_RELEASE, "agent");
            asm volatile("s_waitcnt vmcnt(0)" ::: "memory");
            const unsigned og = xb_add(&bar[XB_TOP], 1u);
            const unsigned tg = og / nx;
            if (og + 1u == (tg + 1u) * nx) xb_add(&bar[XB_TOPGEN], 1u);
            else XB_SPIN(xb_ld(&bar[XB_TOPGEN]) == tg, bar);
            __builtin_amdgcn_fence(__ATOMIC_ACQUIRE, "agent");
            xb_add(&bar[XB_XGEN(b.x)], 1u);
            asm volatile("s_waitcnt vmcnt(0)" ::: "memory");
        } else {
            XB_SPIN(xb_ld(&bar[XB_XGEN(b.x)]) == gen, bar);
            __builtin_amdgcn_fence(__ATOMIC_ACQUIRE, "agent");
            asm volatile("s_waitcnt vmcnt(0)" ::: "memory");
        }
    }
    __syncthreads();
}

__global__ void __launch_bounds__(512, 2) mk_fwd(Args a) {
    extern __shared__ __attribute__((aligned(16))) unsigned char lds_raw[];
    LAS unsigned char* lds = (LAS unsigned char*)lds_raw;
    cg::grid_group grid = cg::this_grid();
    if (threadIdx.x < 16) ((LAS unsigned*)(lds + LDS_BARST))[threadIdx.x] = 0u;
    __syncthreads();
    XcdBarrier xbar = xcd_barrier_post((unsigned*)(a.ws + WS_BAR), (volatile LAS unsigned*)(lds + LDS_BARST));
    const int lo = a.ph_lo, hi = a.ph_hi;
    if (lo < 0) grid.sync();
#define IN(k) (lo <= (k) && (k) < hi)
#define SEAM(k) do { if (IN(k) && IN((k) + 1)) xcd_barrier(xbar); } while (0)
#define PHASE_ENV \
    size_t zoff_ = 0; asm volatile("" : "+s"(zoff_)); unsigned char* ws = a.ws + zoff_;     \
    int tid = threadIdx.x; asm volatile("" : "+v"(tid)); \
    int G = gridDim.x, bx = blockIdx.x; asm volatile("" : "+s"(G), "+s"(bx)); \
    const int lane = tid & 63, wave = __builtin_amdgcn_readfirstlane(tid >> 6); \
    const int vcu = (G % 8 == 0) ? (bx % 8) * (G / 8) + bx / 8 : bx; \
    (void)lane; (void)wave; (void)vcu;
    for (int rep_ = 0; rep_ < MK_REP_PRO; ++rep_) { if (IN(0)) { PHASE_ENV; prologue(a, lds, wave, lane, vcu, G); } if (rep_ + 1 < MK_REP_PRO) { asm volatile("s_waitcnt vmcnt(0)" ::: "memory"); __syncthreads(); } }
    SEAM(0);
    for (int l = 0; l < MK_DBG_LAYERS; ++l) {
        const int p0 = 1 + 8 * l;
        for (int rep_ = 0; rep_ < MK_REP_A; ++rep_) {
        if (IN(p0) && MK_DBG_PH > 0) {
            PHASE_ENV;
            pg8::StaticOrder S; S.init(ws + WS_XB, (const bf16_t*)(ws + WS_WIN) + (size_t)l * NIN * D, T, NIN, D, G, bx);
            pg8::EpiA E{(bf16_t*)(ws + WS_P1), (bf16_t*)(ws + WS_G), (const float*)(ws + WS_RSS), (const float*)(ws + WS_LBS) + l * BW};
            pg8::gemm_phase(lds, tid, D, S, E);
        }
        if (IN(p0) && MK_DBG_PH > 0 && l + 1 < DEPTH && rep_ == 0) {
            PHASE_ENV;
            if (G == 256) { if (bx >= 128) convert_layer(a, ws, l + 1, (bx - 128) * 8 + wave, 1024, (LAS float*)(lds + wave * 16640), lane); }
            else convert_layer(a, ws, l + 1, vcu * 8 + wave, G * 8, (LAS float*)(lds + wave * 16640), lane);
        }
        SEAM(p0);
        }
        for (int rep_ = 0; rep_ < MK_REP_B1; ++rep_) {
        if (IN(p0 + 1) && MK_DBG_PH > 1) {
            PHASE_ENV;
            const bf16_t* P1 = (const bf16_t*)(ws + WS_P1);
            { HPre pre; hgrn_load<false>(pre, P1, vcu, tid);
              for (int u = vcu; u < 1024; u += G) hgrn_pass1(P1, pre, u + G, (bf16_t*)(ws + WS_SL), (float*)(ws + WS_DEC), lds, u, tid, wave, lane); }
            for (int u = vcu; u < 512; u += G) sg_unit(P1, a.sg_ln_g + l * BW, a.sg_ln_b + l * BW, a.w_sg + (size_t)l * 4 * 128 * 128, a.b_sg + l * 4 * 128, (bf16_t*)(ws + WS_ZC), lds, u, wave, lane);
        }
        SEAM(p0 + 1);
        }
        for (int rep_ = 0; rep_ < MK_REP_B2; ++rep_) {
        if (IN(p0 + 2) && MK_DBG_PH > 2) {
            PHASE_ENV;
            hgrn_scan((const bf16_t*)(ws + WS_SL), (bf16_t*)(ws + WS_ST), (const float*)(ws + WS_DEC), vcu * 512 + tid, G * 512);
        }
        SEAM(p0 + 2);
        }
        for (int rep_ = 0; rep_ < MK_REP_B3; ++rep_) {
        if (IN(p0 + 3) && MK_DBG_PH > 3) {
            PHASE_ENV;
            { const bf16_t* P1 = (const bf16_t*)(ws + WS_P1); HPre pre; hgrn_load<true>(pre, P1, vcu, tid);
              for (int u = vcu; u < 1024; u += G) hgrn_pass3(P1, pre, u + G, (const bf16_t*)(ws + WS_ST), a.g_hgrn_out + l * BW, (bf16_t*)(ws + WS_ZA), lds, u, tid, wave, lane); }
            __syncthreads();
            conv_phase((const bf16_t*)(ws + WS_P1), a.w_conv + (size_t)l * 3 * BW, (bf16_t*)(ws + WS_ZB), vcu * 512 + tid, G * 512);
        }
        SEAM(p0 + 3);
        }
        for (int rep_ = 0; rep_ < MK_REP_C; ++rep_) {
        if (IN(p0 + 4) && MK_DBG_PH > 4) {
            PHASE_ENV;
            pg8::BranchOrder S; S.init(ws + WS_ZA, (size_t)(WS_ZB - WS_ZA), (const bf16_t*)(ws + WS_WBR) + (size_t)l * 3 * D * BW, G, bx);
            pg8::EpiC E{(const bf16_t*)(ws + WS_G), (bf16_t*)(ws + WS_MB)};
            pg8::gemm_phase(lds, tid, BW, S, E);
        }
        SEAM(p0 + 4);
        }
        for (int repd_ = 0; repd_ < MK_REP_D; ++repd_) {
        if (IN(p0 + 5) && MK_DBG_PH > 5) {
            PHASE_ENV;
            pg8::StaticOrder S; S.init(ws + WS_MB, (const bf16_t*)(ws + WS_WO) + (size_t)l * D * D, T, D, D, G, bx);
            pg8::EpiRes E{l == 0 ? a.x : (const float*)a.out, a.out, (bf16_t*)(ws + WS_XB), (float*)(ws + WS_RSS), repd_ + 1 < MK_REP_D};
            pg8::gemm_phase(lds, tid, D, S, E);
        }
        SEAM(p0 + 5);
        }
        for (int rep_ = 0; rep_ < MK_REP_E; ++rep_) {
        if (IN(p0 + 6) && MK_DBG_PH > 6) {
            PHASE_ENV;
            pg8::StaticOrder S; S.init(ws + WS_XB, (const bf16_t*)(ws + WS_W1) + (size_t)l * FF * D, T, FF, D, G, bx);
            pg8::EpiE E{(bf16_t*)(ws + WS_H), (const float*)(ws + WS_RSS)};
            pg8::gemm_phase(lds, tid, D, S, E);
        }
        SEAM(p0 + 6);
        }
        for (int repd_ = 0; repd_ < MK_REP_F; ++repd_) {
        if (IN(p0 + 7) && MK_DBG_PH > 7) {
            PHASE_ENV;
            pg8::StaticOrder S; S.init(ws + WS_H, (const bf16_t*)(ws + WS_W2) + (size_t)l * D * FF, T, D, FF, G, bx);
            pg8::EpiRes E{a.out, a.out, (l + 1 < DEPTH) ? (bf16_t*)(ws + WS_XB) : (bf16_t*)nullptr, (float*)(ws + WS_RSS), repd_ + 1 < MK_REP_F};
            pg8::gemm_phase(lds, tid, FF, S, E);
        }
        SEAM(p0 + 7);
        }
        for (int rep_ = 0; rep_ < MK_EXTRA_SYNC; ++rep_) SEAM(p0 + 7);
    }
    if (IN(NPH - 1)) {
        PHASE_ENV;
        const float* rss = (const float*)(ws + WS_RSS); float* X = a.out;
        const int gw = vcu * 8 + wave, NGW = G * 8;
        for (int m = gw; m < T; m += NGW) { const float rs = row_rs(rss, m);
            f32x4* xo = (f32x4*)(X + (size_t)m * D) + lane; const f32x4* gf = (const f32x4*)a.g_final + lane;
#pragma unroll
            for (int j = 0; j < 4; ++j) xo[64 * j] = xo[64 * j] * rs * gf[64 * j]; }
    }
#undef IN
#undef SEAM
}

extern "C" void kernel_launch(void* const* d_in, const int* in_sizes, int n_in, void* d_out, int out_size, void* d_ws, size_t ws_size, hipStream_t stream) {
    static int grid = 0;
    if (grid == 0) {
        if (n_in != 16 || in_sizes[0] != T * D || out_size != T * D || ws_size < WS_END) { fprintf(stderr, "kernel_launch: unexpected shapes (n_in %d, in0 %d, out %d, ws %zu < %zu)\n", n_in, n_in > 0 ? in_sizes[0] : -1, out_size, ws_size, (size_t)WS_END); grid = -1; return; }
        int dev = 0, cus = 0, per_cu = 0;
        hipGetDevice(&dev); hipDeviceGetAttribute(&cus, hipDeviceAttributeMultiprocessorCount, dev);
        if (hipFuncSetAttribute((const void*)mk_fwd, hipFuncAttributeMaxDynamicSharedMemorySize, LDS_BYTES) != hipSuccess) { fprintf(stderr, "kernel_launch: hipFuncSetAttribute failed\n"); grid = -1; return; }
        if (hipOccupancyMaxActiveBlocksPerMultiprocessor(&per_cu, (const void*)mk_fwd, 512, LDS_BYTES) != hipSuccess || per_cu < 1) { fprintf(stderr, "kernel_launch: occupancy query says %d\n", per_cu); per_cu = 1; }
        (void)hipGetLastError();
        grid = cus * 1;
    }
    if (grid < 0) return;
    if (hipMemsetAsync((char*)d_ws + WS_BAR, 0, BAR_ZERO_BYTES, stream) != hipSuccess) { fprintf(stderr, "kernel_launch: memset failed\n"); return; }
    Args a{};
    a.x = (const float*)d_in[0]; a.w_in = (const float*)d_in[1]; a.g_mix = (const float*)d_in[2]; a.lower_bounds = (const float*)d_in[3]; a.g_hgrn_out = (const float*)d_in[4];
    a.w_conv = (const float*)d_in[5]; a.sg_ln_g = (const float*)d_in[6]; a.sg_ln_b = (const float*)d_in[7]; a.w_sg = (const float*)d_in[8]; a.b_sg = (const float*)d_in[9];
    a.w_branch = (const float*)d_in[10]; a.w_o = (const float*)d_in[11]; a.g_ffn = (const float*)d_in[12]; a.w_ff1 = (const float*)d_in[13]; a.w_ff2 = (const float*)d_in[14]; a.g_final = (const float*)d_in[15];
    a.out = (float*)d_out; a.ws = (unsigned char*)d_ws;
    a.ph_lo = 0; a.ph_hi = NPH;
    { void* args[] = {&a}; hipError_t e = hipLaunchCooperativeKernel((const void*)mk_fwd, dim3(grid), dim3(512), args, LDS_BYTES, stream);
      if (e != hipSuccess) fprintf(stderr, "cooperative launch failed: %s (grid %d)\n", hipGetErrorString(e), grid); }
}
```
